# Optimizing an MI355X kernel written in HIP

```python
import numpy as np
import jax, jax.numpy as jnp
from jax import lax

D_MODEL = 2048
BATCH = 2
SEQ = 4096
DEPTH = 2

GRID_W = 64
EPS = 1e-6
NEG_INF = -1e30

NA_HEADS = 8
NA_HEAD_DIM = 128
NA_WIDTH = NA_HEADS * NA_HEAD_DIM
NA_ROWS = 8
NA_COLS = 16
NA_COL_BLOCK = 16
NA_COL_SPAN = NA_COL_BLOCK + NA_COLS

SGU_GROUPS = 8
SGU_GROUP_DIM = 128
SGU_WIDTH = SGU_GROUPS * SGU_GROUP_DIM
SGU_CHUNK = 128

MLA_HEADS = 8
MLA_Q_RANK = 512
MLA_KV_RANK = 512
MLA_NOPE = 128
MLA_ROPE = 64
MLA_V = 128
MLA_WIDTH = MLA_HEADS * MLA_V
MLA_Q_BLOCK = 128
ROPE_THETA = 10000.0

N_BRANCH = 3
IN_SPLITS = [NA_WIDTH, 2 * NA_WIDTH, 3 * NA_WIDTH, 3 * NA_WIDTH + 2 * SGU_WIDTH,
             3 * NA_WIDTH + 2 * SGU_WIDTH + MLA_Q_RANK,
             3 * NA_WIDTH + 2 * SGU_WIDTH + MLA_Q_RANK + MLA_KV_RANK]
IN_COLS = 3 * NA_WIDTH + 2 * SGU_WIDTH + MLA_Q_RANK + MLA_KV_RANK + MLA_ROPE

PEER_HEADS = 8
PEER_N_KEYS = 128
PEER_N_EXPERTS = PEER_N_KEYS * PEER_N_KEYS
PEER_KEY_HALF = 128
PEER_TOPK = 16
PEER_TOKEN_BLOCK = 128

kernel_name = "hybrid_natten_sgu_mla_peer_encoder"


def rms_norm(x, g):
    xf = x.astype(jnp.float32)
    y = xf * lax.rsqrt(jnp.mean(xf * xf, axis=-1, keepdims=True) + EPS)
    return (y * g.astype(jnp.float32)).astype(x.dtype)


def layer_norm(x, g, b):
    xf = x.astype(jnp.float32)
    mu = jnp.mean(xf, axis=-1, keepdims=True)
    var = jnp.mean(jnp.square(xf - mu), axis=-1, keepdims=True)
    y = (xf - mu) * lax.rsqrt(var + EPS)
    return (y * g.astype(jnp.float32) + b.astype(jnp.float32)).astype(x.dtype)


def rope_tables(seq_len):
    inv = 1.0 / (ROPE_THETA ** (jnp.arange(0, MLA_ROPE, 2, dtype=jnp.float32) / MLA_ROPE))
    ang = jnp.arange(seq_len, dtype=jnp.float32)[:, None] * inv[None, :]
    return jnp.cos(ang), jnp.sin(ang)


def apply_rope(x, cos, sin):
    xf = x.astype(jnp.float32)
    x1, x2 = xf[..., :MLA_ROPE // 2], xf[..., MLA_ROPE // 2:]
    return jnp.concatenate([x1 * cos - x2 * sin, x2 * cos + x1 * sin], axis=-1).astype(x.dtype)


def neighborhood_attention(q, k, v, rel_bias):
    B, S, H, hd = q.shape
    rows = S // GRID_W
    kr = min(NA_ROWS, rows)
    scale = hd ** -0.5
    qg = q.reshape(B, rows, GRID_W, H, hd)
    kg = k.reshape(B, rows, GRID_W, H, hd)
    vg = v.reshape(B, rows, GRID_W, H, hd)
    r = np.arange(rows)
    rs = np.clip(r - kr // 2, 0, rows - kr)
    row_idx = rs[:, None] + np.arange(kr)[None, :]
    dr_idx = row_idx - r[:, None] + (NA_ROWS - 1)
    k_band = jnp.take(kg, row_idx, axis=1)
    v_band = jnp.take(vg, row_idx, axis=1)
    outs = []
    for c0 in range(0, GRID_W, NA_COL_BLOCK):
        start = int(np.clip(c0 - NA_COLS // 2, 0, GRID_W - NA_COL_SPAN))
        cq = np.arange(c0, c0 + NA_COL_BLOCK)
        ck = np.arange(start, start + NA_COL_SPAN)
        cs = np.clip(cq - NA_COLS // 2, 0, GRID_W - NA_COLS)
        valid = (ck[None, :] >= cs[:, None]) & (ck[None, :] < cs[:, None] + NA_COLS)
        dc_idx = np.clip(ck[None, :] - cq[:, None] + (NA_COLS - 1), 0, 2 * NA_COLS - 2)
        bias = rel_bias[:, dr_idx[:, None, :, None], dc_idx[None, :, None, :]]
        qb = qg[:, :, c0:c0 + NA_COL_BLOCK]
        kb = k_band[:, :, :, start:start + NA_COL_SPAN]
        vb = v_band[:, :, :, start:start + NA_COL_SPAN]
        s = jnp.einsum('brchd,brkwhd->bhrckw', qb, kb, preferred_element_type=jnp.float32)
        s = s * scale + bias.astype(jnp.float32)[None]
        s = jnp.where(valid[None, None, None, :, None, :], s, NEG_INF)
        shp = s.shape
        p = jax.nn.softmax(s.reshape(shp[:4] + (kr * NA_COL_SPAN,)), axis=-1).reshape(shp).astype(q.dtype)
        outs.append(jnp.einsum('bhrckw,brkwhd->brchd', p, vb))
    o = jnp.concatenate(outs, axis=2)
    return o.reshape(B, S, H * hd)


def spatial_gating(z, ln_g, ln_b, w_s, b_s):
    B, S, _ = z.shape
    z = jax.nn.gelu(z)
    u, v = z[..., :SGU_WIDTH], z[..., SGU_WIDTH:]
    v = layer_norm(v, ln_g, ln_b).reshape(B, S // SGU_CHUNK, SGU_CHUNK, SGU_GROUPS, SGU_GROUP_DIM)
    s = jnp.einsum('gpq,bnqgc->bnpgc', w_s, v) + b_s.T[None, None, :, :, None]
    return u * s.reshape(B, S, SGU_WIDTH)


def latent_attention(c_q, c_kv, k_r, cq_g, ckv_g, w_uq, w_ukv):
    B, S, _ = c_q.shape
    dt = c_q.dtype
    q = (rms_norm(c_q, cq_g) @ w_uq).reshape(B, S, MLA_HEADS, MLA_NOPE + MLA_ROPE)
    kv = (rms_norm(c_kv, ckv_g) @ w_ukv).reshape(B, S, MLA_HEADS, MLA_NOPE + MLA_V)
    q_nope, q_rope = q[..., :MLA_NOPE], q[..., MLA_NOPE:]
    k_nope, v = kv[..., :MLA_NOPE], kv[..., MLA_NOPE:]
    cos, sin = rope_tables(S)
    q_rope = apply_rope(q_rope, cos[:, None, :], sin[:, None, :])
    k_rope = apply_rope(k_r, cos, sin)
    scale = (MLA_NOPE + MLA_ROPE) ** -0.5
    nb = S // MLA_Q_BLOCK
    qn_b = q_nope.reshape(B, nb, MLA_Q_BLOCK, MLA_HEADS, MLA_NOPE).transpose(1, 0, 2, 3, 4)
    qr_b = q_rope.reshape(B, nb, MLA_Q_BLOCK, MLA_HEADS, MLA_ROPE).transpose(1, 0, 2, 3, 4)

    def attend(blk):
        qn, qr = blk
        s = (jnp.einsum('bqhd,bkhd->bhqk', qn, k_nope, preferred_element_type=jnp.float32)
             + jnp.einsum('bqhr,bkr->bhqk', qr, k_rope, preferred_element_type=jnp.float32))
        p = jax.nn.softmax(s * scale, axis=-1).astype(dt)
        return jnp.einsum('bhqk,bkhd->bqhd', p, v)

    o = lax.map(attend, (qn_b, qr_b))
    return o.transpose(1, 0, 2, 3, 4).reshape(B, S, MLA_WIDTH)


def hybrid_mixer(h, w_in, na_bias, sgu_ln_g, sgu_ln_b, sgu_w, sgu_b, cq_g, ckv_g, w_uq, w_ukv,
                 w_a_out, w_b_out, w_c_out, w_gate, b_gate, w_out):
    B, S, D = h.shape
    p = h @ w_in
    qa, ka, va, zb, c_q, c_kv, k_r = jnp.split(p, IN_SPLITS, axis=-1)
    hs = (B, S, NA_HEADS, NA_HEAD_DIM)
    o_a = neighborhood_attention(qa.reshape(hs), ka.reshape(hs), va.reshape(hs), na_bias)
    o_b = spatial_gating(zb, sgu_ln_g, sgu_ln_b, sgu_w, sgu_b)
    o_c = latent_attention(c_q, c_kv, k_r, cq_g, ckv_g, w_uq, w_ukv)
    gates = jax.nn.sigmoid((h @ w_gate + b_gate).astype(jnp.float32)).astype(h.dtype)
    gates = gates.reshape(B, S, N_BRANCH, D)
    merged = (gates[:, :, 0] * (o_a @ w_a_out) + gates[:, :, 1] * (o_b @ w_b_out)
              + gates[:, :, 2] * (o_c @ w_c_out))
    return merged @ w_out


def peer_layer(h, w_query, keys1, keys2, expert_u, expert_v):
    B, S, D = h.shape
    T = B * S
    ht = h.reshape(T, D)
    q = (ht @ w_query).reshape(T, PEER_HEADS, 2, PEER_KEY_HALF)
    s1 = jnp.einsum('thd,hnd->thn', q[:, :, 0], keys1)
    s2 = jnp.einsum('thd,hnd->thn', q[:, :, 1], keys2)
    v1, i1 = lax.top_k(s1, PEER_TOPK)
    v2, i2 = lax.top_k(s2, PEER_TOPK)
    cand = (v1[..., :, None] + v2[..., None, :]).reshape(T, PEER_HEADS, PEER_TOPK * PEER_TOPK)
    cand_idx = (i1[..., :, None] * PEER_N_KEYS + i2[..., None, :]).reshape(T, PEER_HEADS, PEER_TOPK * PEER_TOPK)
    best, pos = lax.top_k(cand, PEER_TOPK)
    idx = jnp.take_along_axis(cand_idx, pos, axis=-1)
    g = jax.nn.softmax(best.astype(jnp.float32), axis=-1).astype(h.dtype)
    nb = T // PEER_TOKEN_BLOCK
    hk = PEER_HEADS * PEER_TOPK
    xb = ht.reshape(nb, PEER_TOKEN_BLOCK, D)
    ib = idx.reshape(nb, PEER_TOKEN_BLOCK, hk)
    gb = g.reshape(nb, PEER_TOKEN_BLOCK, hk)

    def block(args):
        xt, it, gt = args
        u = jnp.take(expert_u, it, axis=0)
        a = jax.nn.gelu(jnp.einsum('td,tkd->tk', xt, u))
        vv = jnp.take(expert_v, it, axis=0)
        return jnp.einsum('tk,tkd->td', a * gt, vv)

    y = lax.map(block, (xb, ib, gb))
    return y.reshape(B, S, D)


def setup_inputs(seed: int = 0) -> dict:
    key = jax.random.key(seed)
    ks = jax.random.split(key, 32)
    f32 = jnp.float32
    nrm = lambda k, shape, s: (jax.random.normal(k, shape, f32) * s)
    L = DEPTH
    return {
        "x": nrm(ks[0], (BATCH, SEQ, D_MODEL), 1.0),
        "norm1_g": 1.0 + nrm(ks[1], (L, D_MODEL), 0.02),
        "w_in": nrm(ks[2], (L, D_MODEL, IN_COLS), D_MODEL ** -0.5),
        "na_rel_bias": nrm(ks[3], (L, NA_HEADS, 2 * NA_ROWS - 1, 2 * NA_COLS - 1), 0.1),
        "sgu_ln_g": 1.0 + nrm(ks[4], (L, SGU_WIDTH), 0.02),
        "sgu_ln_b": nrm(ks[5], (L, SGU_WIDTH), 0.02),
        "sgu_w": nrm(ks[6], (L, SGU_GROUPS, SGU_CHUNK, SGU_CHUNK), SGU_CHUNK ** -0.5),
        "sgu_b": 1.0 + nrm(ks[7], (L, SGU_GROUPS, SGU_CHUNK), 0.02),
        "mla_cq_g": 1.0 + nrm(ks[8], (L, MLA_Q_RANK), 0.02),
        "mla_ckv_g": 1.0 + nrm(ks[9], (L, MLA_KV_RANK), 0.02),
        "mla_w_uq": nrm(ks[10], (L, MLA_Q_RANK, MLA_HEADS * (MLA_NOPE + MLA_ROPE)), MLA_Q_RANK ** -0.5),
        "mla_w_ukv": nrm(ks[11], (L, MLA_KV_RANK, MLA_HEADS * (MLA_NOPE + MLA_V)), MLA_KV_RANK ** -0.5),
        "w_a_out": nrm(ks[12], (L, NA_WIDTH, D_MODEL), NA_WIDTH ** -0.5),
        "w_b_out": nrm(ks[13], (L, SGU_WIDTH, D_MODEL), SGU_WIDTH ** -0.5),
        "w_c_out": nrm(ks[14], (L, MLA_WIDTH, D_MODEL), MLA_WIDTH ** -0.5),
        "w_gate": nrm(ks[15], (L, D_MODEL, N_BRANCH * D_MODEL), D_MODEL ** -0.5),
        "b_gate": nrm(ks[16], (L, N_BRANCH * D_MODEL), 0.02),
        "w_out": nrm(ks[17], (L, D_MODEL, D_MODEL), D_MODEL ** -0.5),
        "norm2_g": 1.0 + nrm(ks[18], (L, D_MODEL), 0.02),
        "peer_w_query": nrm(ks[19], (L, D_MODEL, PEER_HEADS * 2 * PEER_KEY_HALF), D_MODEL ** -0.5),
        "peer_keys1": nrm(ks[20], (L, PEER_HEADS, PEER_N_KEYS, PEER_KEY_HALF), PEER_KEY_HALF ** -0.5),
        "peer_keys2": nrm(ks[21], (L, PEER_HEADS, PEER_N_KEYS, PEER_KEY_HALF), PEER_KEY_HALF ** -0.5),
        "peer_u": nrm(ks[22], (L, PEER_N_EXPERTS, D_MODEL), D_MODEL ** -0.5),
        "peer_v": nrm(ks[23], (L, PEER_N_EXPERTS, D_MODEL), PEER_HEADS ** -0.5),
        "final_g": 1.0 + nrm(ks[24], (D_MODEL,), 0.02),
    }


def reference(x, norm1_g, w_in, na_rel_bias, sgu_ln_g, sgu_ln_b, sgu_w, sgu_b, mla_cq_g, mla_ckv_g,
              mla_w_uq, mla_w_ukv, w_a_out, w_b_out, w_c_out, w_gate, b_gate, w_out, norm2_g,
              peer_w_query, peer_keys1, peer_keys2, peer_u, peer_v, final_g):
    for l in range(DEPTH):
        h = rms_norm(x, norm1_g[l])
        x = x + hybrid_mixer(h, w_in[l], na_rel_bias[l], sgu_ln_g[l], sgu_ln_b[l], sgu_w[l], sgu_b[l],
                             mla_cq_g[l], mla_ckv_g[l], mla_w_uq[l], mla_w_ukv[l],
                             w_a_out[l], w_b_out[l], w_c_out[l], w_gate[l], b_gate[l], w_out[l])
        h = rms_norm(x, norm2_g[l])
        x = x + peer_layer(h, peer_w_query[l], peer_keys1[l], peer_keys2[l], peer_u[l], peer_v[l])
    return rms_norm(x, final_g)
```

```cpp
#include <hip/hip_runtime.h>
#include <cstdio>
#include <cstdint>

constexpr int DM = 2048, NBATCH = 2, SEQ = 4096, T = NBATCH * SEQ, DEPTH = 2, GW = 64;
constexpr int INC = 6208;
constexpr int C_QA = 0, C_KA = 1024, C_VA = 2048, C_ZB = 3072, C_CQ = 5120, C_CKV = 5632, C_KR = 6144;
constexpr int NEXP = 16384;
constexpr float EPS = 1e-6f;

__device__ __forceinline__ float gelu_tanh(float x) {
    const float k = 0.7978845608028654f;
    return 0.5f * x * (1.f + tanhf(k * (x + 0.044715f * x * x * x)));
}
__device__ __forceinline__ float block_sum256(float v, float* red) {
#pragma unroll
    for (int o = 32; o > 0; o >>= 1) v += __shfl_xor(v, o);
    __syncthreads();
    if ((threadIdx.x & 63) == 0) red[threadIdx.x >> 6] = v;
    __syncthreads();
    return red[0] + red[1] + red[2] + red[3];
}
__device__ __forceinline__ float block_max256(float v, float* red) {
#pragma unroll
    for (int o = 32; o > 0; o >>= 1) v = fmaxf(v, __shfl_xor(v, o));
    __syncthreads();
    if ((threadIdx.x & 63) == 0) red[threadIdx.x >> 6] = v;
    __syncthreads();
    return fmaxf(fmaxf(red[0], red[1]), fmaxf(red[2], red[3]));
}

__global__ __launch_bounds__(256) void g_rmsnorm(const float* __restrict__ x, int ldx, const float* __restrict__ g, float* __restrict__ y, int ldy, int w) {
    __shared__ float red[8];
    const float* xr = x + (size_t)blockIdx.x * ldx; float* yr = y + (size_t)blockIdx.x * ldy;
    float s = 0.f;
    for (int i = threadIdx.x; i < w; i += 256) { const float v = xr[i]; s += v * v; }
    s = block_sum256(s, red);
    const float r = rsqrtf(s / (float)w + EPS);
    for (int i = threadIdx.x; i < w; i += 256) yr[i] = xr[i] * r * g[i];
}

template <bool TB>
__global__ __launch_bounds__(256) void g_sgemm(const float* __restrict__ A, int lda, const float* __restrict__ B, int ldb, float* __restrict__ C, int ldc, int K) {
    __shared__ float As[16][68];
    __shared__ float Bs[16][68];
    const int tx = threadIdx.x & 15, ty = threadIdx.x >> 4;
    const int m0 = blockIdx.y * 64, n0 = blockIdx.x * 64;
    float acc[4][4];
#pragma unroll
    for (int i = 0; i < 4; ++i)
#pragma unroll
        for (int j = 0; j < 4; ++j) acc[i][j] = 0.f;
    for (int k0 = 0; k0 < K; k0 += 16) {
        { const int r = threadIdx.x >> 2, kq = (threadIdx.x & 3) * 4;
          const float4 v = *(const float4*)(A + (size_t)(m0 + r) * lda + k0 + kq);
          As[kq + 0][r] = v.x; As[kq + 1][r] = v.y; As[kq + 2][r] = v.z; As[kq + 3][r] = v.w; }
        if (!TB) { const int kk = threadIdx.x >> 4, nq = (threadIdx.x & 15) * 4;
          const float4 v = *(const float4*)(B + (size_t)(k0 + kk) * ldb + n0 + nq);
          Bs[kk][nq + 0] = v.x; Bs[kk][nq + 1] = v.y; Bs[kk][nq + 2] = v.z; Bs[kk][nq + 3] = v.w;
        } else { const int r = threadIdx.x >> 2, kq = (threadIdx.x & 3) * 4;
          const float4 v = *(const float4*)(B + (size_t)(n0 + r) * ldb + k0 + kq);
          Bs[kq + 0][r] = v.x; Bs[kq + 1][r] = v.y; Bs[kq + 2][r] = v.z; Bs[kq + 3][r] = v.w; }
        __syncthreads();
#pragma unroll
        for (int kk = 0; kk < 16; ++kk) {
            const float4 a = *(const float4*)&As[kk][ty * 4];
            const float4 b = *(const float4*)&Bs[kk][tx * 4];
            acc[0][0] += a.x * b.x; acc[0][1] += a.x * b.y; acc[0][2] += a.x * b.z; acc[0][3] += a.x * b.w;
            acc[1][0] += a.y * b.x; acc[1][1] += a.y * b.y; acc[1][2] += a.y * b.z; acc[1][3] += a.y * b.w;
            acc[2][0] += a.z * b.x; acc[2][1] += a.z * b.y; acc[2][2] += a.z * b.z; acc[2][3] += a.z * b.w;
            acc[3][0] += a.w * b.x; acc[3][1] += a.w * b.y; acc[3][2] += a.w * b.z; acc[3][3] += a.w * b.w;
        }
        __syncthreads();
    }
#pragma unroll
    for (int i = 0; i < 4; ++i) {
        float4 o; o.x = acc[i][0]; o.y = acc[i][1]; o.z = acc[i][2]; o.w = acc[i][3];
        *(float4*)(C + (size_t)(m0 + ty * 4 + i) * ldc + n0 + tx * 4) = o;
    }
}

__global__ __launch_bounds__(128) void g_natten(const float* __restrict__ p, const float* __restrict__ bias  , float* __restrict__ ocat) {
    __shared__ float qs[128]; __shared__ float ps[128]; __shared__ int tk[128]; __shared__ float red[4];
    const int t = blockIdx.x, h = blockIdx.y, b = t / SEQ, s = t % SEQ, r = s / GW, c = s % GW;
    int rs = r - 4; rs = rs < 0 ? 0 : (rs > 56 ? 56 : rs);
    int cs = c - 8; cs = cs < 0 ? 0 : (cs > 48 ? 48 : cs);
    const int k = threadIdx.x, kr = rs + (k >> 4), kc = cs + (k & 15);
    const int tkey = b * SEQ + kr * GW + kc;
    qs[k] = p[(size_t)t * INC + C_QA + h * 128 + k]; tk[k] = tkey;
    __syncthreads();
    const float* kp = p + (size_t)tkey * INC + C_KA + h * 128;
    float sc = 0.f;
    for (int d = 0; d < 128; ++d) sc += qs[d] * kp[d];
    sc = sc * 0.08838834764831845f + bias[(h * 15 + (kr - r + 7)) * 31 + (kc - c + 15)];
    float m = sc;
#pragma unroll
    for (int o = 32; o > 0; o >>= 1) m = fmaxf(m, __shfl_xor(m, o));
    if ((k & 63) == 0) red[k >> 6] = m;
    __syncthreads();
    m = fmaxf(red[0], red[1]);
    const float e = expf(sc - m);
    float sum = e;
#pragma unroll
    for (int o = 32; o > 0; o >>= 1) sum += __shfl_xor(sum, o);
    if ((k & 63) == 0) red[2 + (k >> 6)] = sum;
    __syncthreads();
    sum = red[2] + red[3];
    ps[k] = e / sum;
    __syncthreads();
    float o = 0.f;
    for (int j = 0; j < 128; ++j) o += ps[j] * p[(size_t)tk[j] * INC + C_VA + h * 128 + k];
    ocat[(size_t)t * 3072 + h * 128 + k] = o;
}

__global__ __launch_bounds__(256) void g_sgu_prep(const float* __restrict__ p, const float* __restrict__ lng, const float* __restrict__ lnb, float* __restrict__ U, float* __restrict__ VN) {
    __shared__ float red[8];
    const int t = blockIdx.x; const float* z = p + (size_t)t * INC + C_ZB;
    float v[4]; float s = 0.f;
#pragma unroll
    for (int j = 0; j < 4; ++j) { const int i = threadIdx.x + 256 * j; U[(size_t)t * 1024 + i] = gelu_tanh(z[i]); v[j] = gelu_tanh(z[1024 + i]); s += v[j]; }
    const float mu = block_sum256(s, red) * (1.f / 1024.f);
    float q = 0.f;
#pragma unroll
    for (int j = 0; j < 4; ++j) { v[j] -= mu; q += v[j] * v[j]; }
    const float rstd = rsqrtf(block_sum256(q, red) * (1.f / 1024.f) + EPS);
#pragma unroll
    for (int j = 0; j < 4; ++j) { const int i = threadIdx.x + 256 * j; VN[(size_t)t * 1024 + i] = v[j] * rstd * lng[i] + lnb[i]; }
}
__global__ __launch_bounds__(128) void g_sgu_mix(const float* __restrict__ U, const float* __restrict__ VN, const float* __restrict__ ws  , const float* __restrict__ bs  , float* __restrict__ ocat) {
    const int t = blockIdx.x, g = blockIdx.y, c = threadIdx.x, pp = t & 127, tb = t - pp;
    const float* w = ws + ((size_t)g * 128 + pp) * 128;
    float s = 0.f;
    for (int q = 0; q < 128; ++q) s += w[q] * VN[(size_t)(tb + q) * 1024 + g * 128 + c];
    s += bs[g * 128 + pp];
    ocat[(size_t)t * 3072 + 1024 + g * 128 + c] = U[(size_t)t * 1024 + g * 128 + c] * s;
}

__global__ __launch_bounds__(256) void g_mla_rope(float* __restrict__ QM, const float* __restrict__ KV, const float* __restrict__ p, float* __restrict__ KF) {
    const int t = blockIdx.x, s = t % SEQ;
    __shared__ float cs_[32], sn_[32], kr_[64];
    if (threadIdx.x < 32) { const double inv = pow(10000.0, -(double)threadIdx.x / 32.0); const double a = (double)s * inv; cs_[threadIdx.x] = (float)cos(a); sn_[threadIdx.x] = (float)sin(a); }
    if (threadIdx.x >= 64 && threadIdx.x < 128) kr_[threadIdx.x - 64] = p[(size_t)t * INC + C_KR + threadIdx.x - 64];
    __syncthreads();
    { const int h = threadIdx.x >> 5, i = threadIdx.x & 31;
      float* q = QM + (size_t)t * 1536 + h * 192 + 128;
      const float x1 = q[i], x2 = q[32 + i];
      q[i] = x1 * cs_[i] - x2 * sn_[i]; q[32 + i] = x2 * cs_[i] + x1 * sn_[i];
      const float k1 = kr_[i], k2 = kr_[32 + i];
      float* kf = KF + (size_t)t * 1536 + h * 192 + 128;
      kf[i] = k1 * cs_[i] - k2 * sn_[i]; kf[32 + i] = k2 * cs_[i] + k1 * sn_[i]; }
    for (int j = threadIdx.x; j < 1024; j += 256) { const int h = j >> 7, d = j & 127; KF[(size_t)t * 1536 + h * 192 + d] = KV[(size_t)t * 2048 + h * 256 + d]; }
}
__global__ __launch_bounds__(256) void g_softmax_rows(float* __restrict__ S, float scale) {
    __shared__ float red[8];
    float* r = S + (size_t)blockIdx.x * 4096;
    float v[16]; float m = -3.0e38f;
#pragma unroll
    for (int j = 0; j < 16; ++j) { v[j] = r[threadIdx.x + 256 * j] * scale; m = fmaxf(m, v[j]); }
    m = block_max256(m, red);
    float s = 0.f;
#pragma unroll
    for (int j = 0; j < 16; ++j) { v[j] = expf(v[j] - m); s += v[j]; }
    s = block_sum256(s, red);
    const float inv = 1.f / s;
#pragma unroll
    for (int j = 0; j < 16; ++j) r[threadIdx.x + 256 * j] = v[j] * inv;
}
__global__ __launch_bounds__(256) void g_gate_acc(const float* __restrict__ G, const float* __restrict__ bg, const float* __restrict__ tmp, float* __restrict__ merged, int br) {
    const size_t i = (size_t)blockIdx.x * 256 + threadIdx.x; const size_t t = i / DM; const int c = (int)(i % DM);
    const float z = G[t * 6144 + br * 2048 + c] + bg[br * 2048 + c];
    const float g = 1.f / (1.f + expf(-z));
    const float v = g * tmp[i];
    merged[i] = br == 0 ? v : merged[i] + v;
}
__global__ __launch_bounds__(256) void g_add(float* __restrict__ X, const float* __restrict__ a) { const size_t i = (size_t)blockIdx.x * 256 + threadIdx.x; X[i] += a[i]; }
__global__ __launch_bounds__(256) void g_copy(float* __restrict__ X, const float* __restrict__ a) { const size_t i = (size_t)blockIdx.x * 256 + threadIdx.x; X[i] = a[i]; }

__global__ __launch_bounds__(256) void g_peer_select(const float* __restrict__ PQ, const float* __restrict__ keys1, const float* __restrict__ keys2, int* __restrict__ idx, float* __restrict__ gate) {
    __shared__ float q[2048]; __shared__ float sc[2048]; __shared__ float tv[16][16]; __shared__ int ti[16][16]; __shared__ float cand[8][256];
    const int t = blockIdx.x;
    for (int i = threadIdx.x; i < 2048; i += 256) q[i] = PQ[(size_t)t * 2048 + i];
    __syncthreads();
    for (int i = threadIdx.x; i < 2048; i += 256) {
        const int hs = i >> 7, n = i & 127, h = hs >> 1, sd = hs & 1;
        const float* kp = (sd ? keys2 : keys1) + ((size_t)h * 128 + n) * 128; const float* qq = q + h * 256 + sd * 128;
        float s = 0.f; for (int d = 0; d < 128; ++d) s += qq[d] * kp[d];
        sc[i] = s;
    }
    __syncthreads();
    if (threadIdx.x < 16) {
        float* l = sc + threadIdx.x * 128;
        for (int k = 0; k < 16; ++k) { float best = -3.0e38f; int bi = 0; for (int n = 0; n < 128; ++n) { const float v = l[n]; if (v > best) { best = v; bi = n; } } tv[threadIdx.x][k] = best; ti[threadIdx.x][k] = bi; l[bi] = -3.4e38f; }
    }
    __syncthreads();
    { const int h = threadIdx.x >> 5; for (int j = threadIdx.x & 31; j < 256; j += 32) cand[h][j] = tv[h * 2][j >> 4] + tv[h * 2 + 1][j & 15]; }
    __syncthreads();
    if (threadIdx.x < 8) {
        const int h = threadIdx.x; float bv[16]; float mx = -3.0e38f;
#pragma unroll
        for (int k = 0; k < 16; ++k) { float best = -3.0e38f; int bi = 0; for (int n = 0; n < 256; ++n) { const float v = cand[h][n]; if (v > best) { best = v; bi = n; } } cand[h][bi] = -3.4e38f; bv[k] = best; mx = fmaxf(mx, best);
            idx[(size_t)t * 128 + h * 16 + k] = ti[h * 2][bi >> 4] * 128 + ti[h * 2 + 1][bi & 15]; }
        float s = 0.f;
#pragma unroll
        for (int k = 0; k < 16; ++k) { bv[k] = expf(bv[k] - mx); s += bv[k]; }
#pragma unroll
        for (int k = 0; k < 16; ++k) gate[(size_t)t * 128 + h * 16 + k] = bv[k] / s;
    }
}
__global__ __launch_bounds__(256) void g_peer_gather(const float* __restrict__ H, const int* __restrict__ idx, const float* __restrict__ gate, const float* __restrict__ pu, const float* __restrict__ pv, float* __restrict__ X) {
    __shared__ float part[128][4]; __shared__ float w[128]; __shared__ int e_[128];
    const int t = blockIdx.x;
    if (threadIdx.x < 128) e_[threadIdx.x] = idx[(size_t)t * 128 + threadIdx.x];
    float hv[8];
#pragma unroll
    for (int j = 0; j < 8; ++j) hv[j] = H[(size_t)t * DM + j * 256 + threadIdx.x];
    __syncthreads();
    for (int k = 0; k < 128; ++k) {
        const float* u = pu + (size_t)e_[k] * DM; float s = 0.f;
#pragma unroll
        for (int j = 0; j < 8; ++j) s += hv[j] * u[j * 256 + threadIdx.x];
#pragma unroll
        for (int o = 32; o > 0; o >>= 1) s += __shfl_xor(s, o);
        if ((threadIdx.x & 63) == 0) part[k][threadIdx.x >> 6] = s;
    }
    __syncthreads();
    if (threadIdx.x < 128) { const float a = part[threadIdx.x][0] + part[threadIdx.x][1] + part[threadIdx.x][2] + part[threadIdx.x][3]; w[threadIdx.x] = gelu_tanh(a) * gate[(size_t)t * 128 + threadIdx.x]; }
    __syncthreads();
    float y[8];
#pragma unroll
    for (int j = 0; j < 8; ++j) y[j] = 0.f;
    for (int k = 0; k < 128; ++k) { const float* v = pv + (size_t)e_[k] * DM; const float wk = w[k];
#pragma unroll
        for (int j = 0; j < 8; ++j) y[j] += wk * v[j * 256 + threadIdx.x]; }
#pragma unroll
    for (int j = 0; j < 8; ++j) X[(size_t)t * DM + j * 256 + threadIdx.x] += y[j];
}

static void sgemm(hipStream_t st, bool tb, const float* A, int lda, const float* B, int ldb, float* C, int ldc, int M, int N, int K) {
    dim3 grid(N / 64, M / 64);
    if (tb) hipLaunchKernelGGL(g_sgemm<true>, grid, dim3(256), 0, st, A, lda, B, ldb, C, ldc, K);
    else hipLaunchKernelGGL(g_sgemm<false>, grid, dim3(256), 0, st, A, lda, B, ldb, C, ldc, K);
}

extern "C" void kernel_launch(void* const* d_in, const int* in_sizes, int n_in, void* d_out, int out_size, void* d_ws, size_t ws_size, hipStream_t stream) {
    const float* x = (const float*)d_in[0];
    const float* norm1_g = (const float*)d_in[1];  const float* w_in = (const float*)d_in[2];   const float* na_bias = (const float*)d_in[3];
    const float* sgu_ln_g = (const float*)d_in[4]; const float* sgu_ln_b = (const float*)d_in[5]; const float* sgu_w = (const float*)d_in[6]; const float* sgu_b = (const float*)d_in[7];
    const float* cq_g = (const float*)d_in[8];     const float* ckv_g = (const float*)d_in[9];   const float* w_uq = (const float*)d_in[10];  const float* w_ukv = (const float*)d_in[11];
    const float* w_a = (const float*)d_in[12];     const float* w_b = (const float*)d_in[13];    const float* w_c = (const float*)d_in[14];
    const float* w_gate = (const float*)d_in[15];  const float* b_gate = (const float*)d_in[16]; const float* w_out = (const float*)d_in[17];
    const float* norm2_g = (const float*)d_in[18]; const float* w_query = (const float*)d_in[19]; const float* keys1 = (const float*)d_in[20]; const float* keys2 = (const float*)d_in[21];
    const float* peer_u = (const float*)d_in[22];  const float* peer_v = (const float*)d_in[23];  const float* final_g = (const float*)d_in[24];
    float* out = (float*)d_out;

    size_t off = 0; float* base = (float*)d_ws;
    auto take = [&](size_t n) { float* p = base + off; off += (n + 63) / 64 * 64; return p; };
    float* X = take((size_t)T * DM);
    float* H = take((size_t)T * DM);
    float* P = take((size_t)T * INC);
    float* OCAT = take((size_t)T * 3072);
    float* QM = take((size_t)T * 1536);
    float* KV = take((size_t)T * 2048);
    float* KF = take((size_t)T * 1536);
    float* U = take((size_t)T * 1024);
    float* VN = take((size_t)T * 1024);
    float* MERGED = take((size_t)T * DM);
    float* TMP = take((size_t)T * DM);
    int* IDX = (int*)take((size_t)T * 128);
    float* GATE = take((size_t)T * 128);
    float* CQN = MERGED; float* CKVN = MERGED + (size_t)T * 512; float* S = TMP; float* PQ = TMP;
    static bool checked = false;
    if (!checked) { checked = true; if (off * 4 > ws_size) fprintf(stderr, "kernel_launch: workspace too small: need %zu have %zu\n", off * 4, ws_size); if (n_in != 25) fprintf(stderr, "kernel_launch: n_in %d\n", n_in); }
    if (off * 4 > ws_size) return;

    const int NEL = T * DM / 256;
    hipLaunchKernelGGL(g_copy, dim3(NEL), dim3(256), 0, stream, X, x);
    for (int l = 0; l < DEPTH; ++l) {
        const float* Win = w_in + (size_t)l * DM * INC;
        hipLaunchKernelGGL(g_rmsnorm, dim3(T), dim3(256), 0, stream, X, DM, norm1_g + l * DM, H, DM, DM);
        sgemm(stream, false, H, DM, Win, INC, P, INC, T, INC, DM);
        hipLaunchKernelGGL(g_natten, dim3(T, 8), dim3(128), 0, stream, P, na_bias + (size_t)l * 8 * 15 * 31, OCAT);
        hipLaunchKernelGGL(g_sgu_prep, dim3(T), dim3(256), 0, stream, P, sgu_ln_g + l * 1024, sgu_ln_b + l * 1024, U, VN);
        hipLaunchKernelGGL(g_sgu_mix, dim3(T, 8), dim3(128), 0, stream, U, VN, sgu_w + (size_t)l * 8 * 128 * 128, sgu_b + l * 8 * 128, OCAT);
        hipLaunchKernelGGL(g_rmsnorm, dim3(T), dim3(256), 0, stream, P + C_CQ, INC, cq_g + l * 512, CQN, 512, 512);
        hipLaunchKernelGGL(g_rmsnorm, dim3(T), dim3(256), 0, stream, P + C_CKV, INC, ckv_g + l * 512, CKVN, 512, 512);
        sgemm(stream, false, CQN, 512, w_uq + (size_t)l * 512 * 1536, 1536, QM, 1536, T, 1536, 512);
        sgemm(stream, false, CKVN, 512, w_ukv + (size_t)l * 512 * 2048, 2048, KV, 2048, T, 2048, 512);
        hipLaunchKernelGGL(g_mla_rope, dim3(T), dim3(256), 0, stream, QM, KV, P, KF);
        for (int b = 0; b < NBATCH; ++b) for (int h = 0; h < 8; ++h) {
            sgemm(stream, true, QM + (size_t)b * SEQ * 1536 + h * 192, 1536, KF + (size_t)b * SEQ * 1536 + h * 192, 1536, S, 4096, SEQ, SEQ, 192);
            hipLaunchKernelGGL(g_softmax_rows, dim3(SEQ), dim3(256), 0, stream, S, 0.07216878364870322f);
            sgemm(stream, false, S, 4096, KV + (size_t)b * SEQ * 2048 + h * 256 + 128, 2048, OCAT + (size_t)b * SEQ * 3072 + 2048 + h * 128, 3072, SEQ, 128, SEQ);
        }
        sgemm(stream, false, H, DM, w_gate + (size_t)l * DM * 6144, 6144, P, 6144, T, 6144, DM);
        const float* wbr[3] = {w_a + (size_t)l * 1024 * DM, w_b + (size_t)l * 1024 * DM, w_c + (size_t)l * 1024 * DM};
        for (int br = 0; br < 3; ++br) {
            sgemm(stream, false, OCAT + br * 1024, 3072, wbr[br], DM, TMP, DM, T, DM, 1024);
            hipLaunchKernelGGL(g_gate_acc, dim3(NEL), dim3(256), 0, stream, P, b_gate + (size_t)l * 6144, TMP, MERGED, br);
        }
        sgemm(stream, false, MERGED, DM, w_out + (size_t)l * DM * DM, DM, TMP, DM, T, DM, DM);
        hipLaunchKernelGGL(g_add, dim3(NEL), dim3(256), 0, stream, X, TMP);
        hipLaunchKernelGGL(g_rmsnorm, dim3(T), dim3(256), 0, stream, X, DM, norm2_g + l * DM, H, DM, DM);
        sgemm(stream, false, H, DM, w_query + (size_t)l * DM * DM, DM, PQ, DM, T, DM, DM);
        hipLaunchKernelGGL(g_peer_select, dim3(T), dim3(256), 0, stream, PQ, keys1 + (size_t)l * 8 * 128 * 128, keys2 + (size_t)l * 8 * 128 * 128, IDX, GATE);
        hipLaunchKernelGGL(g_peer_gather, dim3(T), dim3(256), 0, stream, H, IDX, GATE, peer_u + (size_t)l * NEXP * DM, peer_v + (size_t)l * NEXP * DM, X);
    }
    hipLaunchKernelGGL(g_rmsnorm, dim3(T), dim3(256), 0, stream, X, DM, final_g, out, DM, DM);
}
```

```cpp
#include <hip/hip_runtime.h>
#include <cstdio>
#include <cstdint>

constexpr int DM = 2048, NBATCH = 2, SEQ = 4096, T = NBATCH * SEQ, DEPTH = 2, GW_ = 64;
constexpr int INC = 6208, NEXP = 16384;
constexpr float EPS = 1e-6f;
constexpr int NA_N = 12544;
constexpr float NA_SCALE = 0.08838834764831845f, MLA_SCALE = 0.07216878364870322f;

typedef unsigned short bf16_t;
typedef short bf16x8 __attribute__((ext_vector_type(8)));
typedef float f32x4 __attribute__((ext_vector_type(4)));
typedef float f32x2 __attribute__((ext_vector_type(2)));
typedef unsigned u32x4 __attribute__((ext_vector_type(4)));
typedef unsigned u32x2 __attribute__((ext_vector_type(2)));
#define LAS __attribute__((address_space(3)))

constexpr size_t MiB = 1u << 20;
constexpr size_t WS_CTL = 0, WS_ROPE = 1 * MiB, WS_W = 2 * MiB, WL_STRIDE = 210 * MiB;
constexpr size_t WO_WA = 0, WO_WUQ = 49 * MiB, WO_WUKV = WO_WUQ + 3 * MiB / 2, WO_WBR = WO_WUKV + 2 * MiB, WO_WOUT = WO_WBR + 12 * MiB, WO_WQ = WO_WOUT + 8 * MiB,
                 WO_KEYS = WO_WQ + 8 * MiB, WO_SGUW = WO_KEYS + MiB / 2, WO_PU = WO_SGUW + MiB / 4, WO_PV = WO_PU + 64 * MiB;
static_assert(WO_PV + 64 * MiB <= WL_STRIDE, "weight map");
constexpr size_t WS_X = 422 * MiB, WS_XB = 486 * MiB, WS_QA = 518 * MiB, WS_KA = 534 * MiB, WS_VA = 550 * MiB, WS_ZB = 566 * MiB, WS_CQ = 598 * MiB, WS_CKV = 606 * MiB,
                 WS_KR = 614 * MiB, WS_GATES = 616 * MiB, WS_QF = 712 * MiB, WS_KF = 736 * MiB, WS_VF = 760 * MiB, WS_OCAT = 776 * MiB, WS_MERGED = 824 * MiB, WS_PQ = 856 * MiB,
                 WS_IDX = 888 * MiB, WS_GW = 892 * MiB, WS_CQSS = 896 * MiB, WS_CKVSS = WS_CQSS + MiB / 4, WS_XSS = WS_CQSS + MiB / 2, WS_RS = WS_XSS + MiB, WS_RS2 = WS_RS + 32768,
                 WS_VN = 900 * MiB  , WS_END = 932 * MiB;

__device__ __forceinline__ float bf2f(unsigned v) { return __uint_as_float(v << 16); }
__device__ __forceinline__ unsigned cvt_pk_bf16(float lo, float hi) { unsigned r; asm volatile("v_cvt_pk_bf16_f32 %0, %1, %2" : "=v"(r) : "v"(lo), "v"(hi)); return r; }
__device__ __forceinline__ unsigned f2bf(float f) { return cvt_pk_bf16(f, 0.f) & 0xffffu; }
__device__ __forceinline__ float fast_tanh(float y) { const float e = __builtin_amdgcn_exp2f(y * 2.8853900817779268f); return 1.f - 2.f * __builtin_amdgcn_rcpf(1.f + e); }
__device__ __forceinline__ float gelu_tanh(float x) { return 0.5f * x * (1.f + fast_tanh(0.7978845608028654f * (x + 0.044715f * x * x * x))); }
__device__ __forceinline__ float sigmoidf_(float z) { return __builtin_amdgcn_rcpf(1.f + __builtin_amdgcn_exp2f(-1.4426950408889634f * z)); }
__device__ __forceinline__ float wave_sum(float v) {
#pragma unroll
    for (int o = 1; o < 64; o <<= 1) v += __shfl_xor(v, o);
    return v;
}

namespace pg8 {
constexpr int BM = 256, BK = 64, HALF = 128, HTB = HALF * BK * 2, STAGE_BYTES = 8 * HTB, NXCD = 8, WGM = 8;
__host__ __device__ __forceinline__ int lds_byte(int r, int c) { const int st = (r >> 4) * 2 + (c >> 5), rr = r & 15, cc = c & 31, ob = rr * 64 + cc * 2; return st * 1024 + (ob ^ (((ob >> 9) & 1) << 5)); }
__host__ __device__ __forceinline__ void stage_rc(int b, int& R, int& C) { const int st = b / 1024, sb = b % 1024, swz = sb ^ (((sb >> 9) & 1) << 5); R = (st >> 1) * 16 + swz / 64; C = (st & 1) * 32 + (swz % 64) / 2; }
__host__ __device__ __forceinline__ int perm32(int rho) { const int n = rho >> 4, i = rho & 15; return 8 * (i >> 2) + 4 * n + (i & 3); }
struct Unit { int pm, pn; };
struct Gemm { const bf16_t* A; const bf16_t* Bt; int M, N, K; };
struct StaticOrder {
    int nM, nN, nwg, G, c;
    __host__ __device__ void init(int M, int N, int G_, int c_) { nM = M / BM; nN = N / BM; nwg = nM * nN; G = G_; c = c_; }
    __host__ __device__ bool next(int i, Unit& u) const {
        const long L = (long)i * G + c; if (L >= nwg) return false;
        int wgid = (int)L; { const int q = nwg / NXCD, r = nwg % NXCD, xcd = wgid % NXCD, off = wgid / NXCD; wgid = (xcd < r ? xcd * (q + 1) : r * (q + 1) + (xcd - r) * q) + off; }
        const int nig = WGM * nN, gid = wgid / nig, fm = gid * WGM, gsz = (nM - fm) < WGM ? (nM - fm) : WGM;
        u.pm = fm + ((wgid % nig) % gsz); u.pn = (wgid % nig) / gsz; return true;
    }
};
template <class Epi, class Sched, bool ALIGN_EPI = false, bool SP2 = false>
__device__ __forceinline__ void gemm_phase(LAS unsigned char* lds, const Gemm g, const Sched& S, const Epi& E) {
    const int tid = threadIdx.x, wid = __builtin_amdgcn_readfirstlane(tid >> 6), lane = tid & 63, wr = wid >> 2, wc = wid & 3, fr = lane & 15, fq = lane >> 4;
    const int K = g.K, nt = K / BK;
    unsigned voffA[2], voffB[2];
#pragma unroll
    for (int i = 0; i < 2; ++i) { int R, C; stage_rc(tid * 16 + i * 8192, R, C); const int Rb = Epi::PERM ? ((R & ~31) + perm32(R & 31)) : R;
        voffA[i] = (unsigned)(R * K + C) * 2u; voffB[i] = (unsigned)(Rb * K + C) * 2u; }
    const size_t kstep = (size_t)(BK * 2);
    const size_t hstep = (size_t)HALF * K * 2;
    const size_t tstep = 2 * hstep;
    const unsigned ldsw = (unsigned)wid * 1024u;
    const int aoff = lds_byte(wr * 64 + fr, fq * 8), boff = lds_byte(wc * 32 + fr, fq * 8);
#define PG8_SA(b, h) (((b) * 2 + (h)) * HTB)
#define PG8_SB(b, h) ((4 + (b) * 2 + (h)) * HTB)
#define PG8_STAGE(bufoff, gbase, voff) do { _Pragma("unroll") for (int _i = 0; _i < 2; ++_i) \
        __builtin_amdgcn_global_load_lds((const unsigned*)((const char*)(gbase) + (voff)[_i]), (LAS unsigned*)(lds + (bufoff) + ldsw + _i * 8192), 16, 0, 0); } while (0)
#define PG8_LDA(dst, b, h) do { _Pragma("unroll") for (int m = 0; m < 4; ++m) _Pragma("unroll") for (int k = 0; k < 2; ++k) dst[m][k] = *(const LAS bf16x8*)(lds + PG8_SA(b, h) + aoff + m * 2048 + k * 1024); } while (0)
#define PG8_LDB(dst, b, h) do { _Pragma("unroll") for (int n = 0; n < 2; ++n) _Pragma("unroll") for (int k = 0; k < 2; ++k) dst[n][k] = *(const LAS bf16x8*)(lds + PG8_SB(b, h) + boff + n * 2048 + k * 1024); } while (0)
#define PG8_MMA(ai, bj, At, Bt) do { __builtin_amdgcn_s_setprio(1); _Pragma("unroll") for (int m = 0; m < 4; ++m) _Pragma("unroll") for (int n = 0; n < 2; ++n) _Pragma("unroll") for (int k = 0; k < 2; ++k) \
        acc[ai][bj][m][n] = __builtin_amdgcn_mfma_f32_16x16x32_bf16(Bt[n][k], At[m][k], acc[ai][bj][m][n], 0, 0, 0); __builtin_amdgcn_s_setprio(0); } while (0)
#define PG8_WAIT_V(n) asm volatile("s_waitcnt vmcnt(" #n ")" ::: "memory")
#define PG8_WAIT_L(n) asm volatile("s_waitcnt lgkmcnt(" #n ")" ::: "memory")
#define PG8_BAR __builtin_amdgcn_s_barrier()
#define PG8_SCHED __builtin_amdgcn_sched_barrier(0)
    Unit cur, nxt; int ui = 0;
    if (!S.next(0, cur)) return;
    f32x4 acc[2][2][4][2];
#pragma unroll
    for (int a = 0; a < 2; ++a)
#pragma unroll
        for (int b = 0; b < 2; ++b)
#pragma unroll
            for (int m = 0; m < 4; ++m)
#pragma unroll
                for (int n = 0; n < 2; ++n) acc[a][b][m][n] = (f32x4){0.f, 0.f, 0.f, 0.f};
    bf16x8 At[4][2], B0[2][2], B1[2][2];
    const char* cA = (const char*)g.A + (size_t)cur.pm * tstep; const char* cB = (const char*)g.Bt + (size_t)cur.pn * tstep;
    if constexpr (SP2) {
        PG8_STAGE(PG8_SB(0, 0), cB, voffB); PG8_STAGE(PG8_SB(0, 1), cB + hstep, voffB); PG8_STAGE(PG8_SA(0, 0), cA, voffA); PG8_STAGE(PG8_SA(0, 1), cA + hstep, voffA);
        if (wr == 1) PG8_BAR;
        PG8_WAIT_V(2); PG8_BAR;
        PG8_STAGE(PG8_SB(1, 0), cB + kstep, voffB); PG8_STAGE(PG8_SA(1, 0), cA + kstep, voffA); PG8_STAGE(PG8_SB(1, 1), cB + hstep + kstep, voffB);
        PG8_WAIT_V(6); PG8_BAR;
    } else {
        PG8_STAGE(PG8_SB(0, 0), cB, voffB); PG8_STAGE(PG8_SA(0, 0), cA, voffA); PG8_STAGE(PG8_SB(0, 1), cB + hstep, voffB); PG8_STAGE(PG8_SA(0, 1), cA + hstep, voffA);
        if (wr == 1) PG8_BAR;
        PG8_WAIT_V(4); PG8_BAR;
        PG8_STAGE(PG8_SB(1, 0), cB + kstep, voffB); PG8_STAGE(PG8_SA(1, 0), cA + kstep, voffA); PG8_STAGE(PG8_SB(1, 1), cB + hstep + kstep, voffB);
        PG8_WAIT_V(6); PG8_BAR;
    }
    for (;;) {
        const bool has_next = S.next(ui + 1, nxt);
        const char* nA = has_next ? (const char*)g.A + (size_t)nxt.pm * tstep : cA; const char* nB = has_next ? (const char*)g.Bt + (size_t)nxt.pn * tstep : cB;
        for (int t = 0; t < nt; t += 2) {
            if constexpr (Epi::KHOOK) { if (t == 16 || t == 32) E.khook(acc, cur, t >> 4, wr, wc, fr, fq); }
            const bool last = (t == nt - 2);
            const char* a1 = cA + (size_t)(t + 1) * kstep;
            const char* a2 = last ? nA : cA + (size_t)(t + 2) * kstep; const char* b2 = last ? nB : cB + (size_t)(t + 2) * kstep;
            const char* a3 = a2 + kstep; const char* b3 = b2 + kstep;
            if constexpr (SP2) {
            PG8_LDB(B0, 0, 0); PG8_LDB(B1, 0, 1); PG8_SCHED; PG8_LDA(At, 0, 0); PG8_STAGE(PG8_SA(1, 1), a1 + hstep, voffA);
            PG8_WAIT_V(8); PG8_WAIT_L(0); PG8_BAR; PG8_MMA(0, 0, At, B0); PG8_MMA(0, 1, At, B1); PG8_BAR; PG8_SCHED;
            PG8_LDA(At, 0, 1); PG8_STAGE(PG8_SB(0, 0), b2, voffB); PG8_STAGE(PG8_SB(0, 1), b2 + hstep, voffB); PG8_STAGE(PG8_SA(0, 0), a2, voffA);
            PG8_WAIT_V(8); PG8_WAIT_L(0); PG8_BAR; PG8_MMA(1, 0, At, B0); PG8_MMA(1, 1, At, B1); PG8_BAR; PG8_SCHED;
            PG8_LDB(B0, 1, 0); PG8_LDB(B1, 1, 1); PG8_SCHED; PG8_LDA(At, 1, 0); PG8_STAGE(PG8_SA(0, 1), a2 + hstep, voffA);
            PG8_WAIT_V(8); PG8_WAIT_L(0); PG8_BAR; PG8_MMA(0, 0, At, B0); PG8_MMA(0, 1, At, B1); PG8_BAR; PG8_SCHED;
            PG8_LDA(At, 1, 1); PG8_STAGE(PG8_SB(1, 0), b3, voffB); PG8_STAGE(PG8_SB(1, 1), b3 + hstep, voffB); PG8_STAGE(PG8_SA(1, 0), a3, voffA);
            PG8_WAIT_V(8); PG8_WAIT_L(0); PG8_BAR; PG8_MMA(1, 0, At, B0); PG8_MMA(1, 1, At, B1); PG8_BAR; PG8_SCHED;
            } else {
            PG8_LDB(B0, 0, 0); PG8_SCHED; PG8_LDA(At, 0, 0); PG8_STAGE(PG8_SA(1, 1), a1 + hstep, voffA);
            PG8_WAIT_L(8); PG8_BAR; PG8_WAIT_L(0); PG8_MMA(0, 0, At, B0); PG8_BAR; PG8_SCHED;
            PG8_LDB(B1, 0, 1); PG8_STAGE(PG8_SB(0, 0), b2, voffB);
            PG8_BAR; PG8_WAIT_L(0); PG8_MMA(0, 1, At, B1); PG8_BAR;
            PG8_LDA(At, 0, 1); PG8_STAGE(PG8_SA(0, 0), a2, voffA);
            PG8_BAR; PG8_WAIT_L(0); PG8_MMA(1, 0, At, B0); PG8_BAR; PG8_SCHED;
            PG8_STAGE(PG8_SB(0, 1), b2 + hstep, voffB);
            PG8_WAIT_V(6); PG8_BAR; PG8_MMA(1, 1, At, B1); PG8_BAR;
            PG8_LDB(B0, 1, 0); PG8_SCHED; PG8_LDA(At, 1, 0); PG8_STAGE(PG8_SA(0, 1), a2 + hstep, voffA);
            PG8_WAIT_L(8); PG8_BAR; PG8_WAIT_L(0); PG8_MMA(0, 0, At, B0); PG8_BAR; PG8_SCHED;
            PG8_LDB(B1, 1, 1); PG8_STAGE(PG8_SB(1, 0), b3, voffB);
            PG8_BAR; PG8_WAIT_L(0); PG8_MMA(0, 1, At, B1); PG8_BAR;
            PG8_LDA(At, 1, 1); PG8_STAGE(PG8_SA(1, 0), a3, voffA);
            PG8_BAR; PG8_WAIT_L(0); PG8_MMA(1, 0, At, B0); PG8_BAR; PG8_SCHED;
            PG8_STAGE(PG8_SB(1, 1), b3 + hstep, voffB);
            PG8_WAIT_V(6); PG8_BAR; PG8_MMA(1, 1, At, B1); PG8_BAR;
            }
        }
        if constexpr (ALIGN_EPI) { if (wr == 0) PG8_BAR; }
        E(acc, cur, wr, wc, fr, fq);
        if (!has_next) break;
#pragma unroll
        for (int a = 0; a < 2; ++a)
#pragma unroll
            for (int b = 0; b < 2; ++b)
#pragma unroll
                for (int m = 0; m < 4; ++m)
#pragma unroll
                    for (int n = 0; n < 2; ++n) acc[a][b][m][n] = (f32x4){0.f, 0.f, 0.f, 0.f};
        cur = nxt; cA = nA; cB = nB; ++ui;
        if constexpr (ALIGN_EPI) { if (wr == 1) PG8_BAR; }
    }
    PG8_WAIT_V(0);
    if constexpr (!ALIGN_EPI) { if (wr == 0) PG8_BAR; }
    PG8_BAR;
#undef PG8_SA
#undef PG8_SB
#undef PG8_STAGE
#undef PG8_LDA
#undef PG8_LDB
#undef PG8_MMA
#undef PG8_WAIT_V
#undef PG8_WAIT_L
#undef PG8_BAR
#undef PG8_SCHED
}
}
using pg8::Unit;
typedef const f32x4 (&AccRef)[2][2][4][2];

__device__ __forceinline__ void store8_bf16(bf16_t* p, f32x4 v0, f32x4 v1) {
    u32x4 w; w.x = cvt_pk_bf16(v0[0], v0[1]); w.y = cvt_pk_bf16(v0[2], v0[3]); w.z = cvt_pk_bf16(v1[0], v1[1]); w.w = cvt_pk_bf16(v1[2], v1[3]); *(u32x4*)p = w;
}
struct EpiA {
    static constexpr bool PERM = true, KHOOK = false;
    unsigned char* ws; const float* bgate;
    __device__ __forceinline__ void khook(f32x4 (&)[2][2][4][2], const Unit&, int, int, int, int, int) const {}
    __device__ __forceinline__ void operator()(AccRef acc, const Unit& u, int wr, int wc, int fr, int fq) const {
        const int pn = u.pn, row0 = u.pm * 256 + wr * 64 + fr, ct = wc * 32 + 8 * fq;
        const float* rs = (const float*)(ws + WS_RS);
        if (pn < 12) {
            bf16_t* base = (bf16_t*)(ws + (pn < 4 ? WS_QA : (pn < 8 ? WS_KA : WS_VA))) + (pn & 3) * 256 + ct; const float sc0 = pn < 4 ? NA_SCALE : 1.f;
#pragma unroll
            for (int ai = 0; ai < 2; ++ai)
#pragma unroll
                for (int m = 0; m < 4; ++m) { const int row = row0 + ai * 128 + m * 16; const float sc = rs[row] * sc0;
#pragma unroll
                    for (int bj = 0; bj < 2; ++bj) store8_bf16(base + (size_t)row * 1024 + bj * 128, acc[ai][bj][m][0] * sc, acc[ai][bj][m][1] * sc); }
        } else if (pn < 20) {
            bf16_t* base = (bf16_t*)(ws + WS_ZB) + (pn - 12) * 256 + ct;
#pragma unroll
            for (int ai = 0; ai < 2; ++ai)
#pragma unroll
                for (int m = 0; m < 4; ++m) { const int row = row0 + ai * 128 + m * 16; const float r = rs[row];
#pragma unroll
                    for (int bj = 0; bj < 2; ++bj) { f32x4 v0 = acc[ai][bj][m][0] * r, v1 = acc[ai][bj][m][1] * r;
#pragma unroll
                        for (int i = 0; i < 4; ++i) { v0[i] = gelu_tanh(v0[i]); v1[i] = gelu_tanh(v1[i]); }
                        store8_bf16(base + (size_t)row * 2048 + bj * 128, v0, v1); } }
        } else if (pn < 24) {
            const int half = (pn - 20) & 1; bf16_t* base = (bf16_t*)(ws + (pn < 22 ? WS_CQ : WS_CKV)) + half * 256 + ct; float* ss = (float*)(ws + (pn < 22 ? WS_CQSS : WS_CKVSS)) + half * 4 + wc;
#pragma unroll
            for (int ai = 0; ai < 2; ++ai)
#pragma unroll
                for (int m = 0; m < 4; ++m) { const int row = row0 + ai * 128 + m * 16; const float r = rs[row]; float s = 0.f;
#pragma unroll
                    for (int bj = 0; bj < 2; ++bj) { const f32x4 v0 = acc[ai][bj][m][0] * r, v1 = acc[ai][bj][m][1] * r;
                        s += (v0[0] * v0[0] + v0[1] * v0[1]) + (v0[2] * v0[2] + v0[3] * v0[3]) + (v1[0] * v1[0] + v1[1] * v1[1]) + (v1[2] * v1[2] + v1[3] * v1[3]);
                        store8_bf16(base + (size_t)row * 512 + bj * 128, v0, v1); }
                    s += __shfl_xor(s, 16); s += __shfl_xor(s, 32);
                    if (fq == 0) ss[(size_t)row * 8] = s; }
        } else if (pn < 48) {
            const int c0 = (pn - 24) * 256 + ct; bf16_t* base = (bf16_t*)(ws + WS_GATES) + c0;
            const f32x4 b00 = *(const f32x4*)(bgate + c0), b01 = *(const f32x4*)(bgate + c0 + 4), b10 = *(const f32x4*)(bgate + c0 + 128), b11 = *(const f32x4*)(bgate + c0 + 132);
#pragma unroll
            for (int ai = 0; ai < 2; ++ai)
#pragma unroll
                for (int m = 0; m < 4; ++m) { const int row = row0 + ai * 128 + m * 16; const float r = rs[row];
#pragma unroll
                    for (int bj = 0; bj < 2; ++bj) { f32x4 v0 = acc[ai][bj][m][0] * r + (bj ? b10 : b00), v1 = acc[ai][bj][m][1] * r + (bj ? b11 : b01);
#pragma unroll
                        for (int i = 0; i < 4; ++i) { v0[i] = sigmoidf_(v0[i]); v1[i] = sigmoidf_(v1[i]); }
                        store8_bf16(base + (size_t)row * 6144 + bj * 128, v0, v1); } }
        } else {
            float* KR = (float*)(ws + WS_KR);
            if (wc < 2) {
#pragma unroll
                for (int ai = 0; ai < 2; ++ai)
#pragma unroll
                    for (int m = 0; m < 4; ++m) { const int row = row0 + ai * 128 + m * 16; const float r = rs[row]; float* p = KR + (size_t)row * 64 + ct; *(f32x4*)p = acc[ai][0][m][0] * r; *(f32x4*)(p + 4) = acc[ai][0][m][1] * r; } }
        }
    }
};
struct EpiQup {
    static constexpr bool PERM = true, KHOOK = false;
    const float* ss; const f32x2* rope; bf16_t* QF;
    __device__ __forceinline__ void khook(f32x4 (&)[2][2][4][2], const Unit&, int, int, int, int, int) const {}
    __device__ __forceinline__ void operator()(AccRef acc, const Unit& u, int wr, int wc, int fr, int fq) const {
        const int row0 = u.pm * 256 + wr * 64 + fr, ct = u.pn * 256 + wc * 32 + 8 * fq;
#pragma unroll
        for (int ai = 0; ai < 2; ++ai)
#pragma unroll
            for (int m = 0; m < 4; ++m) {
                const int row = row0 + ai * 128 + m * 16;
                const f32x4 s0 = *(const f32x4*)(ss + (size_t)row * 8), s1 = *(const f32x4*)(ss + (size_t)row * 8 + 4);
                const float r = rsqrtf(((s0[0] + s0[1]) + (s0[2] + s0[3]) + (s1[0] + s1[1]) + (s1[2] + s1[3])) * (1.f / 512.f) + EPS);
#pragma unroll
                for (int bj = 0; bj < 2; ++bj) { const int col = ct + bj * 128, off = col % 192; f32x4 v0 = acc[ai][bj][m][0] * r, v1 = acc[ai][bj][m][1] * r;
                    if (off >= 128) { const int i0 = (off - 128) >> 1; const f32x2* rp = rope + (size_t)(row & (SEQ - 1)) * 32 + i0;
                        const f32x2 c0 = rp[0], c1 = rp[1], c2 = rp[2], c3 = rp[3];
                        const f32x4 a = v0, b = v1;
                        v0[0] = a[0] * c0.x - a[1] * c0.y; v0[1] = a[1] * c0.x + a[0] * c0.y; v0[2] = a[2] * c1.x - a[3] * c1.y; v0[3] = a[3] * c1.x + a[2] * c1.y;
                        v1[0] = b[0] * c2.x - b[1] * c2.y; v1[1] = b[1] * c2.x + b[0] * c2.y; v1[2] = b[2] * c3.x - b[3] * c3.y; v1[3] = b[3] * c3.x + b[2] * c3.y; }
                    store8_bf16(QF + (size_t)row * 1536 + col, v0, v1); }
            }
    }
};
struct EpiKVup {
    static constexpr bool PERM = true, KHOOK = false;
    const float* ss; bf16_t *KF, *VF;
    __device__ __forceinline__ void khook(f32x4 (&)[2][2][4][2], const Unit&, int, int, int, int, int) const {}
    __device__ __forceinline__ void operator()(AccRef acc, const Unit& u, int wr, int wc, int fr, int fq) const {
        const int row0 = u.pm * 256 + wr * 64 + fr, ct = wc * 32 + 8 * fq, h = u.pn;
#pragma unroll
        for (int ai = 0; ai < 2; ++ai)
#pragma unroll
            for (int m = 0; m < 4; ++m) {
                const int row = row0 + ai * 128 + m * 16;
                const f32x4 s0 = *(const f32x4*)(ss + (size_t)row * 8), s1 = *(const f32x4*)(ss + (size_t)row * 8 + 4);
                const float r = rsqrtf(((s0[0] + s0[1]) + (s0[2] + s0[3]) + (s1[0] + s1[1]) + (s1[2] + s1[3])) * (1.f / 512.f) + EPS);
                store8_bf16(KF + (size_t)row * 1536 + h * 192 + ct, acc[ai][0][m][0] * r, acc[ai][0][m][1] * r);
                store8_bf16(VF + (size_t)row * 1024 + h * 128 + ct, acc[ai][1][m][0] * r, acc[ai][1][m][1] * r);
            }
    }
};
struct EpiMerge {
    static constexpr bool PERM = true, KHOOK = true;
    const bf16_t* GATES; bf16_t* MERGED;
    __device__ __forceinline__ void khook(f32x4 (&acc)[2][2][4][2], const Unit& u, int br, int wr, int wc, int fr, int fq) const {
        const bf16_t* gp = GATES + (size_t)(u.pm * 256 + wr * 64 + fr) * 6144 + (br - 1) * 2048 + u.pn * 256 + wc * 32 + 8 * fq;
#pragma unroll
        for (int ai = 0; ai < 2; ++ai)
#pragma unroll
            for (int m = 0; m < 4; ++m)
#pragma unroll
                for (int bj = 0; bj < 2; ++bj) { const bf16_t* q = gp + (size_t)(ai * 128 + m * 16) * 6144 + bj * 128; const u32x4 gp_ = *(const u32x4*)q, gn_ = *(const u32x4*)(q + 2048);
                    f32x4 r0, r1;
                    r0[0] = bf2f(gp_[0] & 0xffffu) * __builtin_amdgcn_rcpf(fmaxf(bf2f(gn_[0] & 0xffffu), 1e-30f)); r0[1] = bf2f(gp_[0] >> 16) * __builtin_amdgcn_rcpf(fmaxf(bf2f(gn_[0] >> 16), 1e-30f));
                    r0[2] = bf2f(gp_[1] & 0xffffu) * __builtin_amdgcn_rcpf(fmaxf(bf2f(gn_[1] & 0xffffu), 1e-30f)); r0[3] = bf2f(gp_[1] >> 16) * __builtin_amdgcn_rcpf(fmaxf(bf2f(gn_[1] >> 16), 1e-30f));
                    r1[0] = bf2f(gp_[2] & 0xffffu) * __builtin_amdgcn_rcpf(fmaxf(bf2f(gn_[2] & 0xffffu), 1e-30f)); r1[1] = bf2f(gp_[2] >> 16) * __builtin_amdgcn_rcpf(fmaxf(bf2f(gn_[2] >> 16), 1e-30f));
                    r1[2] = bf2f(gp_[3] & 0xffffu) * __builtin_amdgcn_rcpf(fmaxf(bf2f(gn_[3] & 0xffffu), 1e-30f)); r1[3] = bf2f(gp_[3] >> 16) * __builtin_amdgcn_rcpf(fmaxf(bf2f(gn_[3] >> 16), 1e-30f));
                    acc[ai][bj][m][0] *= r0; acc[ai][bj][m][1] *= r1;
                    asm volatile("" ::: "memory"); }
    }
    __device__ __forceinline__ void operator()(AccRef acc, const Unit& u, int wr, int wc, int fr, int fq) const {
        const int row0 = u.pm * 256 + wr * 64 + fr, ct = u.pn * 256 + wc * 32 + 8 * fq;
#pragma unroll
        for (int ai = 0; ai < 2; ++ai)
#pragma unroll
            for (int m = 0; m < 4; ++m) { const int row = row0 + ai * 128 + m * 16;
#pragma unroll
                for (int bj = 0; bj < 2; ++bj) { const u32x4 g = *(const u32x4*)(GATES + (size_t)row * 6144 + 4096 + ct + bj * 128);
                    f32x4 v0 = acc[ai][bj][m][0], v1 = acc[ai][bj][m][1];
                    v0[0] *= fmaxf(bf2f(g[0] & 0xffffu), 1e-30f); v0[1] *= fmaxf(bf2f(g[0] >> 16), 1e-30f); v0[2] *= fmaxf(bf2f(g[1] & 0xffffu), 1e-30f); v0[3] *= fmaxf(bf2f(g[1] >> 16), 1e-30f);
                    v1[0] *= fmaxf(bf2f(g[2] & 0xffffu), 1e-30f); v1[1] *= fmaxf(bf2f(g[2] >> 16), 1e-30f); v1[2] *= fmaxf(bf2f(g[3] & 0xffffu), 1e-30f); v1[3] *= fmaxf(bf2f(g[3] >> 16), 1e-30f);
                    store8_bf16(MERGED + (size_t)row * 2048 + ct + bj * 128, v0, v1); }
                asm volatile("" ::: "memory"); }
    }
};
struct EpiOut {
    static constexpr bool PERM = false, KHOOK = false;
    const float* base; float* X; bf16_t* XB; float* XSS;
    __device__ __forceinline__ void khook(f32x4 (&)[2][2][4][2], const Unit&, int, int, int, int, int) const {}
    __device__ __forceinline__ void operator()(AccRef acc, const Unit& u, int wr, int wc, int fr, int fq) const {
        const int row0 = u.pm * 256 + wr * 64 + fr, col0 = u.pn * 256 + wc * 32 + 4 * fq;
#pragma unroll
        for (int ai = 0; ai < 2; ++ai)
#pragma unroll
            for (int m = 0; m < 4; ++m) { const int row = row0 + ai * 128 + m * 16; const size_t off = (size_t)row * DM + col0; float s = 0.f;
#pragma unroll
                for (int bj = 0; bj < 2; ++bj)
#pragma unroll
                    for (int n = 0; n < 2; ++n) { const f32x4 v = *(const f32x4*)(base + off + bj * 128 + n * 16) + acc[ai][bj][m][n];
                        *(f32x4*)(X + off + bj * 128 + n * 16) = v; u32x2 w; w.x = cvt_pk_bf16(v[0], v[1]); w.y = cvt_pk_bf16(v[2], v[3]); *(u32x2*)(XB + off + bj * 128 + n * 16) = w;
                        s += (v[0] * v[0] + v[1] * v[1]) + (v[2] * v[2] + v[3] * v[3]); }
                s += __shfl_xor(s, 16); s += __shfl_xor(s, 32);
                if (fq == 0) XSS[(size_t)row * 32 + u.pn * 4 + wc] = s; }
    }
};
struct EpiQuery {
    static constexpr bool PERM = true, KHOOK = false;
    const float* XSS; bf16_t* PQ; float* RS2;
    __device__ __forceinline__ void khook(f32x4 (&)[2][2][4][2], const Unit&, int, int, int, int, int) const {}
    __device__ __forceinline__ void operator()(AccRef acc, const Unit& u, int wr, int wc, int fr, int fq) const {
        const int row0 = u.pm * 256 + wr * 64 + fr, ct = u.pn * 256 + wc * 32 + 8 * fq;
#pragma unroll
        for (int ai = 0; ai < 2; ++ai)
#pragma unroll
            for (int m = 0; m < 4; ++m) { const int row = row0 + ai * 128 + m * 16; float s = 0.f;
#pragma unroll
                for (int j = 0; j < 8; ++j) { const f32x4 v = *(const f32x4*)(XSS + (size_t)row * 32 + 4 * j); s += (v[0] + v[1]) + (v[2] + v[3]); }
                const float r = rsqrtf(s * (1.f / DM) + EPS);
                if (u.pn == 0 && wc == 0 && fq == 0) RS2[row] = r;
#pragma unroll
                for (int bj = 0; bj < 2; ++bj) store8_bf16(PQ + (size_t)row * 2048 + ct + bj * 128, acc[ai][bj][m][0] * r, acc[ai][bj][m][1] * r); }
    }
};

template <int MAP> __device__ __forceinline__ int colmap(int n) {
    if (MAP == 1) { const int h = n / 192, o = n % 192; if (o < 128) return n; const int j = o - 128; return h * 192 + 128 + (j >> 1) + 32 * (j & 1); }
    if (MAP == 2) return (n >> 1) + 32 * (n & 1);
    return n;
}
template <int MAP> __device__ __forceinline__ void transpose_item(const float* W, int ldw, int c0, int ncols, bf16_t* WT, int r0, int ldt, int koff, const float* scale, LAS float* scr, int item, int lane) {
    const int nblk = ncols / 32, kb = item / nblk, nb = item % nblk, k0 = 64 * kb, n0 = 32 * nb;
    const int sc = c0 + colmap<MAP>(n0 + (lane & 31));
#pragma unroll 8
    for (int i = 0; i < 32; ++i) { const int kk = 2 * i + (lane >> 5); float v = W[(size_t)(k0 + kk) * ldw + sc]; if (scale) v *= scale[k0 + kk]; scr[kk * 33 + (lane & 31)] = v; }
    asm volatile("s_waitcnt lgkmcnt(0)" ::: "memory");
    const int c = lane & 7;
#pragma unroll
    for (int j = 0; j < 4; ++j) { const int n = (lane >> 3) + 8 * j; const LAS float* s = scr + (8 * c) * 33 + n;
        u32x4 o; o.x = cvt_pk_bf16(s[0 * 33], s[1 * 33]); o.y = cvt_pk_bf16(s[2 * 33], s[3 * 33]); o.z = cvt_pk_bf16(s[4 * 33], s[5 * 33]); o.w = cvt_pk_bf16(s[6 * 33], s[7 * 33]);
        *(u32x4*)(WT + (size_t)(r0 + n0 + n) * ldt + koff + k0 + 8 * c) = o; }
    asm volatile("s_waitcnt lgkmcnt(0)" ::: "memory");
}
__device__ __forceinline__ void convert_item(const float* src, bf16_t* dst, const float* scale, int lane) {
#pragma unroll
    for (int j = 0; j < 4; ++j) { const int e = (j * 64 + lane) * 8; f32x4 a = *(const f32x4*)(src + e), b = *(const f32x4*)(src + e + 4);
        if (scale) { a = a * *(const f32x4*)(scale + e); b = b * *(const f32x4*)(scale + e + 4); }
        store8_bf16(dst + e, a, b); }
}

struct Args {
    const float* in[25]; float* out; unsigned char* ws; int ph_lo, ph_hi, layer, pad;
};
constexpr int LDS_BYTES = 147456;
constexpr int NWAVES = 8;

__device__ __forceinline__ void p0_prologue(const Args& a, LAS unsigned char* lds, int gw, int NGW, int wave, int lane) {
    LAS float* scr = (LAS float*)(lds + wave * 16384);
    unsigned char* ws = a.ws;
    for (int l = 0; l < DEPTH; ++l) {
        unsigned char* wl = ws + WS_W + (size_t)l * WL_STRIDE;
        bf16_t* WA = (bf16_t*)(wl + WO_WA); bf16_t* WUQ = (bf16_t*)(wl + WO_WUQ); bf16_t* WUKV = (bf16_t*)(wl + WO_WUKV); bf16_t* WBR = (bf16_t*)(wl + WO_WBR);
        bf16_t* WOUT = (bf16_t*)(wl + WO_WOUT); bf16_t* WQ = (bf16_t*)(wl + WO_WQ);
        const float* n1g = a.in[1] + l * DM; const float* n2g = a.in[18] + l * DM;
        const float* w_in = a.in[2] + (size_t)l * DM * INC; const float* w_gate = a.in[15] + (size_t)l * DM * 6144;
        constexpr int I1 = 32 * 192, I2 = 32 * 192, I3 = 32 * 2, I4 = 8 * 48, I5 = 8 * 64, I6 = 16 * 64, I9 = 32 * 64, I10 = 32 * 64;
        constexpr int NIT = I1 + I2 + I3 + I4 + I5 + 3 * I6 + I9 + I10;
        for (int it = gw; it < NIT; it += NGW) {
            int r = it;
            if (r < I1) { transpose_item<0>(w_in, INC, 0, 6144, WA, 0, DM, 0, n1g, scr, r, lane); continue; } r -= I1;
            if (r < I2) { transpose_item<0>(w_gate, 6144, 0, 6144, WA, 6144, DM, 0, n1g, scr, r, lane); continue; } r -= I2;
            if (r < I3) { transpose_item<2>(w_in, INC, 6144, 64, WA, 12288, DM, 0, n1g, scr, r, lane); continue; } r -= I3;
            if (r < I4) { transpose_item<1>(a.in[10] + (size_t)l * 512 * 1536, 1536, 0, 1536, WUQ, 0, 512, 0, a.in[8] + l * 512, scr, r, lane); continue; } r -= I4;
            if (r < I5) { transpose_item<0>(a.in[11] + (size_t)l * 512 * 2048, 2048, 0, 2048, WUKV, 0, 512, 0, a.in[9] + l * 512, scr, r, lane); continue; } r -= I5;
            if (r < 3 * I6) { const int br = r / I6; transpose_item<0>((br == 0 ? a.in[12] : (br == 1 ? a.in[13] : a.in[14])) + (size_t)l * 1024 * DM, DM, 0, DM, WBR, 0, 3072, br * 1024, nullptr, scr, r % I6, lane); continue; } r -= 3 * I6;
            if (r < I9) { transpose_item<0>(a.in[17] + (size_t)l * DM * DM, DM, 0, DM, WOUT, 0, DM, 0, nullptr, scr, r, lane); continue; } r -= I9;
            transpose_item<0>(a.in[19] + (size_t)l * DM * DM, DM, 0, DM, WQ, 0, DM, 0, n2g, scr, r, lane);
        }
        for (int it = gw; it < 192; it += NGW) { u32x4 z = {0u, 0u, 0u, 0u};
#pragma unroll
            for (int j = 0; j < 4; ++j) *(u32x4*)(WA + (size_t)(12352 + it) * DM + (j * 64 + lane) * 8) = z; }
        bf16_t* KEYS = (bf16_t*)(wl + WO_KEYS); bf16_t* SGUW = (bf16_t*)(wl + WO_SGUW); bf16_t* PU = (bf16_t*)(wl + WO_PU); bf16_t* PV = (bf16_t*)(wl + WO_PV);
        constexpr int C1 = 64, C3 = 64, CP = NEXP, NCV = 2 * C1 + C3 + 2 * CP;
        for (int it = gw; it < NCV; it += NGW) {
            int r = it;
            if (r < C1) { convert_item(a.in[20] + (size_t)l * 131072 + (size_t)r * 2048, KEYS + (size_t)r * 2048, nullptr, lane); continue; } r -= C1;
            if (r < C1) { convert_item(a.in[21] + (size_t)l * 131072 + (size_t)r * 2048, KEYS + 131072 + (size_t)r * 2048, nullptr, lane); continue; } r -= C1;
            if (r < C3) { convert_item(a.in[6] + (size_t)l * 131072 + (size_t)r * 2048, SGUW + (size_t)r * 2048, nullptr, lane); continue; } r -= C3;
            if (r < CP) { convert_item(a.in[22] + ((size_t)l * NEXP + r) * DM, PU + (size_t)r * DM, n2g, lane); continue; } r -= CP;
            convert_item(a.in[23] + ((size_t)l * NEXP + r) * DM, PV + (size_t)r * DM, nullptr, lane);
        }
    }
    f32x2* rope = (f32x2*)(ws + WS_ROPE);
    for (int it = gw; it < SEQ * 32 / 64; it += NGW) { const int e = it * 64 + lane, s = e >> 5, i = e & 31;
        const float inv = exp2f(-(float)i * (13.287712379549449f / 32.f)); const float ang = (float)s * inv; float sn, cs; sincosf(ang, &sn, &cs); rope[e] = (f32x2){cs, sn}; }
    const float* x = a.in[0]; bf16_t* XB = (bf16_t*)(ws + WS_XB); float* RS = (float*)(ws + WS_RS);
    for (int t = gw; t < T; t += NGW) { float s = 0.f;
#pragma unroll
        for (int j = 0; j < 4; ++j) { const int e = (j * 64 + lane) * 8; const f32x4 p = *(const f32x4*)(x + (size_t)t * DM + e), q = *(const f32x4*)(x + (size_t)t * DM + e + 4);
            s += (p[0] * p[0] + p[1] * p[1]) + (p[2] * p[2] + p[3] * p[3]) + (q[0] * q[0] + q[1] * q[1]) + (q[2] * q[2] + q[3] * q[3]); store8_bf16(XB + (size_t)t * DM + e, p, q); }
        s = wave_sum(s); if (lane == 0) RS[t] = rsqrtf(s * (1.f / DM) + EPS); }
}

enum Phase { PH_P0 = 0, PH_A = 1, PH_B = 2, PH_C = 3, PH_D = 4, PH_E = 5, PH_F = 6, PH_G1 = 7, PH_G2 = 8, PH_N = 9 };

__global__ void __launch_bounds__(NWAVES * 64, 2) mk_fwd(Args args) {
    extern __shared__ __attribute__((aligned(16))) unsigned char lds_raw[];
    LAS unsigned char* lds = (LAS unsigned char*)lds_raw;
    const int tid = threadIdx.x, lane = tid & 63, wave = __builtin_amdgcn_readfirstlane(tid >> 6);
    const int G = gridDim.x, bx = blockIdx.x, vcu = (G % 8 == 0) ? (bx % 8) * (G / 8) + bx / 8 : bx;
    const int gw = vcu * NWAVES + wave, NGW = G * NWAVES;
    unsigned char* ws = args.ws; const int l = args.layer;
    unsigned char* wl = ws + WS_W + (size_t)l * WL_STRIDE;
    const int lo = args.ph_lo, hi = args.ph_hi;
#define IN(k) (lo <= (k) && (k) < hi)
    if (IN(PH_P0)) p0_prologue(args, lds, gw, NGW, wave, lane);
    if (IN(PH_A)) {
        pg8::Gemm g{(const bf16_t*)(ws + WS_XB), (const bf16_t*)(wl + WO_WA), T, NA_N, DM}; pg8::StaticOrder S; S.init(T, NA_N, G, bx);
        EpiA E{ws, args.in[16] + (size_t)l * 6144};
        pg8::gemm_phase<EpiA, pg8::StaticOrder, true, true>(lds, g, S, E);
    }
    if (IN(PH_B)) {
        { pg8::Gemm g{(const bf16_t*)(ws + WS_CQ), (const bf16_t*)(wl + WO_WUQ), T, 1536, 512}; pg8::StaticOrder S; S.init(T, 1536, G, bx);
          EpiQup E{(const float*)(ws + WS_CQSS), (const f32x2*)(ws + WS_ROPE), (bf16_t*)(ws + WS_QF)};
          pg8::gemm_phase<EpiQup, pg8::StaticOrder, true, true>(lds, g, S, E); }
        { pg8::Gemm g{(const bf16_t*)(ws + WS_CKV), (const bf16_t*)(wl + WO_WUKV), T, 2048, 512}; pg8::StaticOrder S; S.init(T, 2048, G, bx);
          EpiKVup E{(const float*)(ws + WS_CKVSS), (bf16_t*)(ws + WS_KF), (bf16_t*)(ws + WS_VF)};
          pg8::gemm_phase<EpiKVup, pg8::StaticOrder, true, true>(lds, g, S, E); }
        { const float* KR = (const float*)(ws + WS_KR); const f32x2* rope = (const f32x2*)(ws + WS_ROPE); bf16_t* KF = (bf16_t*)(ws + WS_KF);
          for (int t = gw; t < T; t += NGW) { const int i = lane & 31; const f32x2 x = *(const f32x2*)(KR + (size_t)t * 64 + 2 * i); const f32x2 cs = rope[(size_t)(t & (SEQ - 1)) * 32 + i];
              const unsigned w = cvt_pk_bf16(x.x * cs.x - x.y * cs.y, x.y * cs.x + x.x * cs.y);
#pragma unroll
              for (int hh = 0; hh < 4; ++hh) { const int h = hh * 2 + (lane >> 5); *(unsigned*)(KF + (size_t)t * 1536 + h * 192 + 128 + 2 * i) = w; } } }
    }
    if (IN(PH_D)) {
        pg8::Gemm g{(const bf16_t*)(ws + WS_OCAT), (const bf16_t*)(wl + WO_WBR), T, DM, 3072}; pg8::StaticOrder S; S.init(T, DM, G, bx);
        EpiMerge E{(const bf16_t*)(ws + WS_GATES), (bf16_t*)(ws + WS_MERGED)};
        pg8::gemm_phase<EpiMerge, pg8::StaticOrder, true, true>(lds, g, S, E);
    }
    if (IN(PH_E)) {
        pg8::Gemm g{(const bf16_t*)(ws + WS_MERGED), (const bf16_t*)(wl + WO_WOUT), T, DM, DM}; pg8::StaticOrder S; S.init(T, DM, G, bx);
        EpiOut E{l == 0 ? args.in[0] : (const float*)(ws + WS_X), (float*)(ws + WS_X), (bf16_t*)(ws + WS_XB), (float*)(ws + WS_XSS)};
        pg8::gemm_phase<EpiOut, pg8::StaticOrder, true, true>(lds, g, S, E);
    }
    if (IN(PH_F)) {
        pg8::Gemm g{(const bf16_t*)(ws + WS_XB), (const bf16_t*)(wl + WO_WQ), T, DM, DM}; pg8::StaticOrder S; S.init(T, DM, G, bx);
        EpiQuery E{(const float*)(ws + WS_XSS), (bf16_t*)(ws + WS_PQ), (float*)(ws + WS_RS2)};
        pg8::gemm_phase<EpiQuery, pg8::StaticOrder, true, true>(lds, g, S, E);
    }
#undef IN
}

__device__ __forceinline__ float ldbf(const bf16_t* p) { return bf2f((unsigned)*p); }
__global__ __launch_bounds__(128) void n_natten(const bf16_t* __restrict__ QA, const bf16_t* __restrict__ KA, const bf16_t* __restrict__ VA, const float* __restrict__ bias, bf16_t* __restrict__ OCAT) {
    __shared__ float qs[128]; __shared__ float ps[128]; __shared__ int tk[128]; __shared__ float red[4];
    const int t = blockIdx.x, h = blockIdx.y, b = t / SEQ, s = t % SEQ, r = s / GW_, c = s % GW_;
    int rs = r - 4; rs = rs < 0 ? 0 : (rs > 56 ? 56 : rs);
    int cs = c - 8; cs = cs < 0 ? 0 : (cs > 48 ? 48 : cs);
    const int k = threadIdx.x, kr = rs + (k >> 4), kc = cs + (k & 15);
    const int tkey = b * SEQ + kr * GW_ + kc;
    qs[k] = ldbf(QA + (size_t)t * 1024 + h * 128 + k); tk[k] = tkey;
    __syncthreads();
    const bf16_t* kp = KA + (size_t)tkey * 1024 + h * 128;
    float sc = 0.f;
    for (int d = 0; d < 128; ++d) sc += qs[d] * ldbf(kp + d);
    sc += bias[(h * 15 + (kr - r + 7)) * 31 + (kc - c + 15)];
    float m = sc;
#pragma unroll
    for (int o = 32; o > 0; o >>= 1) m = fmaxf(m, __shfl_xor(m, o));
    if ((k & 63) == 0) red[k >> 6] = m;
    __syncthreads();
    m = fmaxf(red[0], red[1]);
    const float e = expf(sc - m);
    float sum = e;
#pragma unroll
    for (int o = 32; o > 0; o >>= 1) sum += __shfl_xor(sum, o);
    if ((k & 63) == 0) red[2 + (k >> 6)] = sum;
    __syncthreads();
    sum = red[2] + red[3];
    ps[k] = e / sum;
    __syncthreads();
    float o = 0.f;
    for (int j = 0; j < 128; ++j) o += ps[j] * ldbf(VA + (size_t)tk[j] * 1024 + h * 128 + k);
    OCAT[(size_t)t * 3072 + h * 128 + k] = (bf16_t)f2bf(o);
}
__device__ __forceinline__ float block_sum256(float v, float* red) {
#pragma unroll
    for (int o = 32; o > 0; o >>= 1) v += __shfl_xor(v, o);
    __syncthreads();
    if ((threadIdx.x & 63) == 0) red[threadIdx.x >> 6] = v;
    __syncthreads();
    return red[0] + red[1] + red[2] + red[3];
}
__global__ __launch_bounds__(256) void n_sgu_prep(const bf16_t* __restrict__ ZB, const float* __restrict__ lng, const float* __restrict__ lnb, float* __restrict__ VN) {
    __shared__ float red[8];
    const int t = blockIdx.x; const bf16_t* z = ZB + (size_t)t * 2048 + 1024;
    float v[4]; float s = 0.f;
#pragma unroll
    for (int j = 0; j < 4; ++j) { v[j] = ldbf(z + threadIdx.x + 256 * j); s += v[j]; }
    const float mu = block_sum256(s, red) * (1.f / 1024.f);
    float q = 0.f;
#pragma unroll
    for (int j = 0; j < 4; ++j) { v[j] -= mu; q += v[j] * v[j]; }
    const float rstd = rsqrtf(block_sum256(q, red) * (1.f / 1024.f) + EPS);
#pragma unroll
    for (int j = 0; j < 4; ++j) { const int i = threadIdx.x + 256 * j; VN[(size_t)t * 1024 + i] = v[j] * rstd * lng[i] + lnb[i]; }
}
__global__ __launch_bounds__(128) void n_sgu_mix(const bf16_t* __restrict__ ZB, const float* __restrict__ VN, const float* __restrict__ wsg, const float* __restrict__ bs, bf16_t* __restrict__ OCAT) {
    const int t = blockIdx.x, g = blockIdx.y, c = threadIdx.x, pp = t & 127, tb = t - pp;
    const float* w = wsg + ((size_t)g * 128 + pp) * 128;
    float s = 0.f;
    for (int q = 0; q < 128; ++q) s += w[q] * VN[(size_t)(tb + q) * 1024 + g * 128 + c];
    s += bs[g * 128 + pp];
    OCAT[(size_t)t * 3072 + 1024 + g * 128 + c] = (bf16_t)f2bf(ldbf(ZB + (size_t)t * 2048 + g * 128 + c) * s);
}
__global__ __launch_bounds__(256) void n_mla_attn(const bf16_t* __restrict__ QF, const bf16_t* __restrict__ KF, const bf16_t* __restrict__ VF, bf16_t* __restrict__ OCAT) {
    extern __shared__ __attribute__((aligned(16))) unsigned char smem[];
    float* S = (float*)smem; float* q = S + 8 * 4096; float* li = q + 8 * 192;
    const int blk = blockIdx.x, h = blockIdx.y, t0 = blk * 8, b = t0 / SEQ, tid = threadIdx.x;
    for (int i = tid; i < 8 * 192; i += 256) q[i] = ldbf(QF + (size_t)(t0 + i / 192) * 1536 + h * 192 + i % 192);
    __syncthreads();
    for (int ch = 0; ch < 16; ++ch) { const int key = ch * 256 + tid; const bf16_t* kp = KF + (size_t)(b * SEQ + key) * 1536 + h * 192;
        float s[8];
#pragma unroll
        for (int j = 0; j < 8; ++j) s[j] = 0.f;
        for (int d = 0; d < 192; d += 8) { const u32x4 kv = *(const u32x4*)(kp + d);
#pragma unroll
            for (int e = 0; e < 4; ++e) { const float k0 = bf2f(kv[e] & 0xffffu), k1 = bf2f(kv[e] >> 16);
#pragma unroll
                for (int j = 0; j < 8; ++j) s[j] += q[j * 192 + d + 2 * e] * k0 + q[j * 192 + d + 2 * e + 1] * k1; } }
#pragma unroll
        for (int j = 0; j < 8; ++j) S[j * 4096 + key] = s[j] * MLA_SCALE; }
    __syncthreads();
    { const int w = tid >> 6, ln = tid & 63;
      for (int qq = 2 * w; qq < 2 * w + 2; ++qq) { float m = -3.0e38f; for (int i = ln; i < 4096; i += 64) m = fmaxf(m, S[qq * 4096 + i]);
#pragma unroll
          for (int o = 32; o > 0; o >>= 1) m = fmaxf(m, __shfl_xor(m, o));
          float sum = 0.f; for (int i = ln; i < 4096; i += 64) { const float e = expf(S[qq * 4096 + i] - m); S[qq * 4096 + i] = e; sum += e; }
          sum = wave_sum(sum); if (ln == 0) li[qq] = 1.f / sum; } }
    __syncthreads();
    { const int d = tid & 127, q0 = (tid >> 7) * 4; float o[4] = {0.f, 0.f, 0.f, 0.f}; const bf16_t* vp = VF + (size_t)(b * SEQ) * 1024 + h * 128 + d;
      for (int key = 0; key < 4096; ++key) { const float v = ldbf(vp + (size_t)key * 1024);
#pragma unroll
          for (int j = 0; j < 4; ++j) o[j] += S[(q0 + j) * 4096 + key] * v; }
#pragma unroll
      for (int j = 0; j < 4; ++j) OCAT[(size_t)(t0 + q0 + j) * 3072 + 2048 + h * 128 + d] = (bf16_t)f2bf(o[j] * li[q0 + j]); }
}
__global__ __launch_bounds__(256) void n_peer_select(const bf16_t* __restrict__ PQ, const float* __restrict__ keys1, const float* __restrict__ keys2, int* __restrict__ idx, float* __restrict__ gate) {
    __shared__ float q[2048]; __shared__ float sc[2048]; __shared__ float tv[16][16]; __shared__ int ti[16][16]; __shared__ float cand[8][256];
    const int t = blockIdx.x;
    for (int i = threadIdx.x; i < 2048; i += 256) q[i] = ldbf(PQ + (size_t)t * 2048 + i);
    __syncthreads();
    for (int i = threadIdx.x; i < 2048; i += 256) {
        const int hs = i >> 7, n = i & 127, h = hs >> 1, sd = hs & 1;
        const float* kp = (sd ? keys2 : keys1) + ((size_t)h * 128 + n) * 128; const float* qq = q + h * 256 + sd * 128;
        float s = 0.f; for (int d = 0; d < 128; ++d) s += qq[d] * kp[d];
        sc[i] = s;
    }
    __syncthreads();
    if (threadIdx.x < 16) {
        float* lst = sc + threadIdx.x * 128;
        for (int k = 0; k < 16; ++k) { float best = -3.0e38f; int bi = 0; for (int n = 0; n < 128; ++n) { const float v = lst[n]; if (v > best) { best = v; bi = n; } } tv[threadIdx.x][k] = best; ti[threadIdx.x][k] = bi; lst[bi] = -3.4e38f; }
    }
    __syncthreads();
    { const int h = threadIdx.x >> 5; for (int j = threadIdx.x & 31; j < 256; j += 32) cand[h][j] = tv[h * 2][j >> 4] + tv[h * 2 + 1][j & 15]; }
    __syncthreads();
    if (threadIdx.x < 8) {
        const int h = threadIdx.x; float bv[16]; float mx = -3.0e38f;
#pragma unroll
        for (int k = 0; k < 16; ++k) { float best = -3.0e38f; int bi = 0; for (int n = 0; n < 256; ++n) { const float v = cand[h][n]; if (v > best) { best = v; bi = n; } } cand[h][bi] = -3.4e38f; bv[k] = best; mx = fmaxf(mx, best);
            idx[(size_t)t * 128 + h * 16 + k] = ti[h * 2][bi >> 4] * 128 + ti[h * 2 + 1][bi & 15]; }
        float s = 0.f;
#pragma unroll
        for (int k = 0; k < 16; ++k) { bv[k] = expf(bv[k] - mx); s += bv[k]; }
#pragma unroll
        for (int k = 0; k < 16; ++k) gate[(size_t)t * 128 + h * 16 + k] = bv[k] / s;
    }
}
__global__ __launch_bounds__(256) void n_peer_gather(const bf16_t* XBc, const float* __restrict__ RS2, const int* __restrict__ idx, const float* __restrict__ gate, const bf16_t* __restrict__ pu, const bf16_t* __restrict__ pv,
                                                     float* X, bf16_t* XB, float* __restrict__ RS, const float* __restrict__ final_g, float* __restrict__ out) {
    __shared__ float part[128][4]; __shared__ float w[128]; __shared__ int e_[128]; __shared__ float red[8];
    const int t = blockIdx.x;
    if (threadIdx.x < 128) e_[threadIdx.x] = idx[(size_t)t * 128 + threadIdx.x];
    float hv[8];
#pragma unroll
    for (int j = 0; j < 8; ++j) hv[j] = ldbf(XBc + (size_t)t * DM + j * 256 + threadIdx.x);
    const float rs2 = RS2[t];
    __syncthreads();
    for (int k = 0; k < 128; ++k) {
        const bf16_t* u = pu + (size_t)e_[k] * DM; float s = 0.f;
#pragma unroll
        for (int j = 0; j < 8; ++j) s += hv[j] * ldbf(u + j * 256 + threadIdx.x);
#pragma unroll
        for (int o = 32; o > 0; o >>= 1) s += __shfl_xor(s, o);
        if ((threadIdx.x & 63) == 0) part[k][threadIdx.x >> 6] = s;
    }
    __syncthreads();
    if (threadIdx.x < 128) { const float a = rs2 * (part[threadIdx.x][0] + part[threadIdx.x][1] + part[threadIdx.x][2] + part[threadIdx.x][3]); w[threadIdx.x] = gelu_tanh(a) * gate[(size_t)t * 128 + threadIdx.x]; }
    __syncthreads();
    float y[8];
#pragma unroll
    for (int j = 0; j < 8; ++j) y[j] = 0.f;
    for (int k = 0; k < 128; ++k) { const bf16_t* v = pv + (size_t)e_[k] * DM; const float wk = w[k];
#pragma unroll
        for (int j = 0; j < 8; ++j) y[j] += wk * ldbf(v + j * 256 + threadIdx.x); }
    float ss = 0.f;
#pragma unroll
    for (int j = 0; j < 8; ++j) { y[j] += X[(size_t)t * DM + j * 256 + threadIdx.x]; ss += y[j] * y[j]; }
    const float r = rsqrtf(block_sum256(ss, red) * (1.f / DM) + EPS);
    if (out) {
#pragma unroll
        for (int j = 0; j < 8; ++j) out[(size_t)t * DM + j * 256 + threadIdx.x] = y[j] * r * final_g[j * 256 + threadIdx.x];
    } else {
#pragma unroll
        for (int j = 0; j < 8; ++j) { X[(size_t)t * DM + j * 256 + threadIdx.x] = y[j]; XB[(size_t)t * DM + j * 256 + threadIdx.x] = (bf16_t)f2bf(y[j]); }
        if (threadIdx.x == 0) RS[t] = r;
    }
}

extern "C" void kernel_launch(void* const* d_in, const int* in_sizes, int n_in, void* d_out, int out_size, void* d_ws, size_t ws_size, hipStream_t stream) {
    static int grid = 0;
    if (grid == 0) {
        if (n_in != 25 || ws_size < WS_END || out_size != T * DM) { fprintf(stderr, "kernel_launch: bad shapes: n_in %d ws %zu out %d\n", n_in, ws_size, out_size); grid = -1; return; }
        int dev = 0, cus = 0; hipGetDevice(&dev); hipDeviceGetAttribute(&cus, hipDeviceAttributeMultiprocessorCount, dev);
        if (hipFuncSetAttribute((const void*)mk_fwd, hipFuncAttributeMaxDynamicSharedMemorySize, LDS_BYTES) != hipSuccess) { fprintf(stderr, "kernel_launch: hipFuncSetAttribute failed\n"); grid = -1; return; }
        if (hipFuncSetAttribute((const void*)n_mla_attn, hipFuncAttributeMaxDynamicSharedMemorySize, 140000) != hipSuccess) { fprintf(stderr, "kernel_launch: hipFuncSetAttribute(2) failed\n"); grid = -1; return; }
        grid = cus;
    }
    if (grid < 0) return;
    unsigned char* ws = (unsigned char*)d_ws;
    Args a{};
    for (int i = 0; i < 25; ++i) a.in[i] = (const float*)d_in[i];
    a.out = (float*)d_out; a.ws = ws;
    auto run = [&](int ph, int layer) { a.ph_lo = ph; a.ph_hi = ph + 1; a.layer = layer; hipLaunchKernelGGL(mk_fwd, dim3(grid), dim3(NWAVES * 64), LDS_BYTES, stream, a); };
    run(PH_P0, 0);
    for (int l = 0; l < DEPTH; ++l) {
        unsigned char* wl = ws + WS_W + (size_t)l * WL_STRIDE;
        run(PH_A, l);
        hipLaunchKernelGGL(n_natten, dim3(T, 8), dim3(128), 0, stream, (const bf16_t*)(ws + WS_QA), (const bf16_t*)(ws + WS_KA), (const bf16_t*)(ws + WS_VA), a.in[3] + (size_t)l * 8 * 15 * 31, (bf16_t*)(ws + WS_OCAT));
        hipLaunchKernelGGL(n_sgu_prep, dim3(T), dim3(256), 0, stream, (const bf16_t*)(ws + WS_ZB), a.in[4] + l * 1024, a.in[5] + l * 1024, (float*)(ws + WS_VN));
        hipLaunchKernelGGL(n_sgu_mix, dim3(T, 8), dim3(128), 0, stream, (const bf16_t*)(ws + WS_ZB), (const float*)(ws + WS_VN), a.in[6] + (size_t)l * 131072, a.in[7] + l * 1024, (bf16_t*)(ws + WS_OCAT));
        run(PH_B, l);
        hipLaunchKernelGGL(n_mla_attn, dim3(T / 8, 8), dim3(256), 140000, stream, (const bf16_t*)(ws + WS_QF), (const bf16_t*)(ws + WS_KF), (const bf16_t*)(ws + WS_VF), (bf16_t*)(ws + WS_OCAT));
        run(PH_D, l);
        run(PH_E, l);
        run(PH_F, l);
        hipLaunchKernelGGL(n_peer_select, dim3(T), dim3(256), 0, stream, (const bf16_t*)(ws + WS_PQ), a.in[20] + (size_t)l * 131072, a.in[21] + (size_t)l * 131072, (int*)(ws + WS_IDX), (float*)(ws + WS_GW));
        hipLaunchKernelGGL(n_peer_gather, dim3(T), dim3(256), 0, stream, (const bf16_t*)(ws + WS_XB), (const float*)(ws + WS_RS2), (const int*)(ws + WS_IDX), (const float*)(ws + WS_GW),
                           (const bf16_t*)(wl + WO_PU), (const bf16_t*)(wl + WO_PV), (float*)(ws + WS_X), (bf16_t*)(ws + WS_XB), (float*)(ws + WS_RS), a.in[24], l == DEPTH - 1 ? (float*)d_out : (float*)nullptr);
    }
}
```

```cpp
#include <hip/hip_runtime.h>
#include <hip/hip_cooperative_groups.h>
namespace cg = cooperative_groups;
#include <cstdio>
#include <cstdint>
#include <cstddef>

constexpr int DM = 2048, NBATCH = 2, SEQ = 4096, T = NBATCH * SEQ, DEPTH = 2, GW_ = 64;
constexpr int INC = 6208, NEXP = 16384;
constexpr float EPS = 1e-6f;
constexpr int NA_N = 12544;
constexpr float NA_SCALE = 0.08838834764831845f, MLA_SCALE = 0.07216878364870322f;

typedef unsigned short bf16_t;
typedef short bf16x8 __attribute__((ext_vector_type(8)));
typedef float f32x4 __attribute__((ext_vector_type(4)));
typedef float f32x2 __attribute__((ext_vector_type(2)));
typedef unsigned u32x4 __attribute__((ext_vector_type(4)));
typedef unsigned u32x2 __attribute__((ext_vector_type(2)));
typedef int i32x4_t __attribute__((ext_vector_type(4)));
#define LAS __attribute__((address_space(3)))

constexpr size_t MiB = 1u << 20;
constexpr size_t WS_CTL = 0, WS_ROPE = 1 * MiB, WS_W = 2 * MiB, WL_STRIDE = 210 * MiB;
constexpr size_t WO_WA = 0, WO_WUQ = 49 * MiB, WO_WUKV = WO_WUQ + 3 * MiB / 2, WO_WBR = WO_WUKV + 2 * MiB, WO_WOUT = WO_WBR + 12 * MiB, WO_WQ = WO_WOUT + 8 * MiB,
                 WO_KEYS = WO_WQ + 8 * MiB, WO_SGUW = WO_KEYS + MiB / 2, WO_PU = WO_SGUW + MiB / 4, WO_PV = WO_PU + 64 * MiB, WO_KLO = WO_PV + 64 * MiB;
static_assert(WO_KLO + MiB / 2 <= WL_STRIDE, "weight map");
constexpr size_t WS_X = 422 * MiB, WS_XB = 486 * MiB, WS_QA = 518 * MiB, WS_KA = 534 * MiB, WS_VA = 550 * MiB, WS_ZB = 566 * MiB, WS_CQ = 598 * MiB, WS_CKV = 606 * MiB,
                 WS_KR = 614 * MiB, WS_GATES = 616 * MiB, WS_QF = 712 * MiB, WS_KF = 736 * MiB, WS_VF = 760 * MiB, WS_OCAT = 776 * MiB, WS_MERGED = 824 * MiB, WS_PQ = 856 * MiB  , WS_ZST = 898 * MiB  , WS_PART = 856 * MiB  , WS_SC = WS_QF  ,
                 WS_IDX = 888 * MiB, WS_GW = 892 * MiB, WS_CQSS = 896 * MiB, WS_CKVSS = WS_CQSS + MiB / 4, WS_XSS = WS_CQSS + MiB / 2, WS_RS = WS_XSS + MiB, WS_RS2 = WS_RS + 32768,
                 WS_XQ = 900 * MiB  , WS_WGQ = 916 * MiB  , WS_SA = 970 * MiB  , WS_SB = WS_SA + 65536  ,
                 WS_END = 972 * MiB;
constexpr size_t CTL_CMAX = 65536;
constexpr size_t CTL_BYTES = 65536;

__device__ __forceinline__ float bf2f(unsigned v) { return __uint_as_float(v << 16); }
typedef __bf16 bf16x2_t __attribute__((ext_vector_type(2)));
typedef float f32x2_t __attribute__((ext_vector_type(2)));
__device__ __forceinline__ unsigned cvt_pk_bf16(float lo, float hi) { const f32x2_t v = {lo, hi}; return __builtin_bit_cast(unsigned, __builtin_convertvector(v, bf16x2_t)); }
__device__ __forceinline__ unsigned f2bf(float f) { return cvt_pk_bf16(f, 0.f) & 0xffffu; }
__device__ __forceinline__ float fast_tanh(float y) { const float e = __builtin_amdgcn_exp2f(y * 2.8853900817779268f); return 1.f - 2.f * __builtin_amdgcn_rcpf(1.f + e); }
__device__ __forceinline__ float gelu_tanh(float x) { return 0.5f * x * (1.f + fast_tanh(0.7978845608028654f * (x + 0.044715f * x * x * x))); }
__device__ __forceinline__ float sigmoidf_(float z) { return __builtin_amdgcn_rcpf(1.f + __builtin_amdgcn_exp2f(-1.4426950408889634f * z)); }
__device__ __forceinline__ float wave_sum(float v) {
#pragma unroll
    for (int o = 1; o < 64; o <<= 1) v += __shfl_xor(v, o);
    return v;
}

__device__ __forceinline__ int otid(int wave_s) { int t; asm volatile("v_mbcnt_lo_u32_b32 %0, -1, 0\n\tv_mbcnt_hi_u32_b32 %0, -1, %0" : "=&v"(t)); return (wave_s << 6) | t; }
namespace pg8 {
constexpr int BM = 256, BK = 64, HALF = 128, HTB = HALF * BK * 2, STAGE_BYTES = 8 * HTB, NXCD = 8, WGM = 8;
__host__ __device__ __forceinline__ int lds_byte(int r, int c) { const int st = (r >> 4) * 2 + (c >> 5), rr = r & 15, cc = c & 31, ob = rr * 64 + cc * 2; return st * 1024 + (ob ^ (((ob >> 9) & 1) << 5)); }
__host__ __device__ __forceinline__ void stage_rc(int b, int& R, int& C) { const int st = b / 1024, sb = b % 1024, swz = sb ^ (((sb >> 9) & 1) << 5); R = (st >> 1) * 16 + swz / 64; C = (st & 1) * 32 + (swz % 64) / 2; }
__host__ __device__ __forceinline__ int perm32(int rho) { const int n = rho >> 4, i = rho & 15; return 8 * (i >> 2) + 4 * n + (i & 3); }
struct Unit { int pm, pn; };
struct Gemm { const bf16_t* A; const bf16_t* Bt; int M, N, K; long dA2 = 0; int split = 0x7fffffff; };
struct StaticOrder {
    int nM, nN, nwg, G, c;
    __host__ __device__ void init(int M, int N, int G_, int c_) { nM = M / BM; nN = N / BM; nwg = nM * nN; G = G_; c = c_; }
    __host__ __device__ bool next(int i, Unit& u) const {
        const long L = (long)i * G + c; if (L >= nwg) return false;
        int wgid = (int)L; { const int q = nwg / NXCD, r = nwg % NXCD, xcd = wgid % NXCD, off = wgid / NXCD; wgid = (xcd < r ? xcd * (q + 1) : r * (q + 1) + (xcd - r) * q) + off; }
        const int nig = WGM * nN, gid = wgid / nig, fm = gid * WGM, gsz = (nM - fm) < WGM ? (nM - fm) : WGM;
        u.pm = fm + ((wgid % nig) % gsz); u.pn = (wgid % nig) / gsz; return true;
    }
};
typedef int i32x4 __attribute__((ext_vector_type(4)));
template <bool I8> struct AccSel { typedef f32x4 T; };
template <> struct AccSel<true> { typedef i32x4 T; };
__device__ __forceinline__ f32x4 mma1(bf16x8 a, bf16x8 b, f32x4 c) { return __builtin_amdgcn_mfma_f32_16x16x32_bf16(a, b, c, 0, 0, 0); }
__device__ __forceinline__ i32x4 mma1(bf16x8 a, bf16x8 b, i32x4 c) { return __builtin_amdgcn_mfma_i32_16x16x64_i8(__builtin_bit_cast(i32x4, a), __builtin_bit_cast(i32x4, b), c, 0, 0, 0); }
template <class Epi, class Sched, bool ALIGN_EPI = false, bool SP2 = false, bool I8 = false>
__device__ __forceinline__ void gemm_phase(LAS unsigned char* lds, const Gemm g, const Sched& S, const Epi& E, const int tid) {
    const int wid = __builtin_amdgcn_readfirstlane(tid >> 6), lane = tid & 63, wr = wid >> 2, wc = wid & 3, fr = lane & 15, fq = lane >> 4;
    const int K = g.K, nt = K / BK;
    unsigned voffA[2], voffB[2];
#pragma unroll
    for (int i = 0; i < 2; ++i) { int R, C; stage_rc(tid * 16 + i * 8192, R, C); const int Rb = Epi::PERM ? ((R & ~31) + perm32(R & 31)) : R;
        voffA[i] = (unsigned)(R * K + C) * 2u; voffB[i] = (unsigned)(Rb * K + C) * 2u; }
    const size_t kstep = (size_t)(BK * 2);
    const size_t hstep = (size_t)HALF * K * 2;
    const size_t tstep = 2 * hstep;
    const unsigned ldsw = (unsigned)wid * 1024u;
    const int aoff = lds_byte(wr * 64 + fr, fq * 8), boff = lds_byte(wc * 32 + fr, fq * 8);
#define PG8_SA(b, h) (((b) * 2 + (h)) * HTB)
#define PG8_SB(b, h) ((4 + (b) * 2 + (h)) * HTB)
#define PG8_STAGE(bufoff, gbase, voff) do { _Pragma("unroll") for (int _i = 0; _i < 2; ++_i) \
        __builtin_amdgcn_global_load_lds((const unsigned*)((const char*)(gbase) + (voff)[_i]), (LAS unsigned*)(lds + (bufoff) + ldsw + _i * 8192), 16, 0, 0); } while (0)
#define PG8_LDA(dst, b, h) do { _Pragma("unroll") for (int m = 0; m < 4; ++m) _Pragma("unroll") for (int k = 0; k < 2; ++k) dst[m][k] = *(const LAS bf16x8*)(lds + PG8_SA(b, h) + aoff + m * 2048 + k * 1024); } while (0)
#define PG8_LDB(dst, b, h) do { _Pragma("unroll") for (int n = 0; n < 2; ++n) _Pragma("unroll") for (int k = 0; k < 2; ++k) dst[n][k] = *(const LAS bf16x8*)(lds + PG8_SB(b, h) + boff + n * 2048 + k * 1024); } while (0)
#define PG8_MMA(ai, bj, At, Bt) do { __builtin_amdgcn_s_setprio(1); _Pragma("unroll") for (int m = 0; m < 4; ++m) _Pragma("unroll") for (int n = 0; n < 2; ++n) _Pragma("unroll") for (int k = 0; k < 2; ++k) \
        acc[ai][bj][m][n] = mma1(Bt[n][k], At[m][k], acc[ai][bj][m][n]); __builtin_amdgcn_s_setprio(0); } while (0)
#define PG8_WAIT_V(n) asm volatile("s_waitcnt vmcnt(" #n ")" ::: "memory")
#define PG8_WAIT_L(n) asm volatile("s_waitcnt lgkmcnt(" #n ")" ::: "memory")
#define PG8_BAR __builtin_amdgcn_s_barrier()
#define PG8_SCHED __builtin_amdgcn_sched_barrier(0)
    Unit cur, nxt; int ui = 0;
    if (!S.next(0, cur)) return;
    typedef typename AccSel<I8>::T acc_t; acc_t acc[2][2][4][2];
#pragma unroll
    for (int a = 0; a < 2; ++a)
#pragma unroll
        for (int b = 0; b < 2; ++b)
#pragma unroll
            for (int m = 0; m < 4; ++m)
#pragma unroll
                for (int n = 0; n < 2; ++n) acc[a][b][m][n] = acc_t{};
    bf16x8 At[4][2], B0[2][2], B1[2][2];
    const char* cA = (const char*)g.A + (cur.pn >= g.split ? g.dA2 : 0L) + (size_t)cur.pm * tstep; const char* cB = (const char*)g.Bt + (size_t)cur.pn * tstep;
    if constexpr (SP2) {
        PG8_STAGE(PG8_SB(0, 0), cB, voffB); PG8_STAGE(PG8_SB(0, 1), cB + hstep, voffB); PG8_STAGE(PG8_SA(0, 0), cA, voffA); PG8_STAGE(PG8_SA(0, 1), cA + hstep, voffA);
        if (wr == 1) PG8_BAR;
        PG8_WAIT_V(2); PG8_BAR;
        PG8_STAGE(PG8_SB(1, 0), cB + kstep, voffB); PG8_STAGE(PG8_SA(1, 0), cA + kstep, voffA); PG8_STAGE(PG8_SB(1, 1), cB + hstep + kstep, voffB);
        PG8_WAIT_V(6); PG8_BAR;
    } else {
        PG8_STAGE(PG8_SB(0, 0), cB, voffB); PG8_STAGE(PG8_SA(0, 0), cA, voffA); PG8_STAGE(PG8_SB(0, 1), cB + hstep, voffB); PG8_STAGE(PG8_SA(0, 1), cA + hstep, voffA);
        if (wr == 1) PG8_BAR;
        PG8_WAIT_V(4); PG8_BAR;
        PG8_STAGE(PG8_SB(1, 0), cB + kstep, voffB); PG8_STAGE(PG8_SA(1, 0), cA + kstep, voffA); PG8_STAGE(PG8_SB(1, 1), cB + hstep + kstep, voffB);
        PG8_WAIT_V(6); PG8_BAR;
    }
    for (;;) {
        const bool has_next = S.next(ui + 1, nxt);
        const char* nA = has_next ? (const char*)g.A + (nxt.pn >= g.split ? g.dA2 : 0L) + (size_t)nxt.pm * tstep : cA; const char* nB = has_next ? (const char*)g.Bt + (size_t)nxt.pn * tstep : cB;
        for (int t = 0; t < nt; t += 2) {
            if constexpr (Epi::KHOOK) { if (t == 16 || t == 32) E.khook(acc, cur, t >> 4, wr, wc, fr, fq); }
            const bool last = (t == nt - 2);
            const char* a1 = cA + (size_t)(t + 1) * kstep;
            const char* a2 = last ? nA : cA + (size_t)(t + 2) * kstep; const char* b2 = last ? nB : cB + (size_t)(t + 2) * kstep;
            const char* a3 = a2 + kstep; const char* b3 = b2 + kstep;
            if constexpr (SP2) {
            PG8_LDB(B0, 0, 0); PG8_LDB(B1, 0, 1); PG8_SCHED; PG8_LDA(At, 0, 0); PG8_STAGE(PG8_SA(1, 1), a1 + hstep, voffA);
            PG8_WAIT_V(8); PG8_WAIT_L(0); PG8_BAR; PG8_MMA(0, 0, At, B0); PG8_MMA(0, 1, At, B1); PG8_BAR; PG8_SCHED;
            PG8_LDA(At, 0, 1); PG8_STAGE(PG8_SB(0, 0), b2, voffB); PG8_STAGE(PG8_SB(0, 1), b2 + hstep, voffB); PG8_STAGE(PG8_SA(0, 0), a2, voffA);
            PG8_WAIT_V(8); PG8_WAIT_L(0); PG8_BAR; PG8_MMA(1, 0, At, B0); PG8_MMA(1, 1, At, B1); PG8_BAR; PG8_SCHED;
            PG8_LDB(B0, 1, 0); PG8_LDB(B1, 1, 1); PG8_SCHED; PG8_LDA(At, 1, 0); PG8_STAGE(PG8_SA(0, 1), a2 + hstep, voffA);
            PG8_WAIT_V(8); PG8_WAIT_L(0); PG8_BAR; PG8_MMA(0, 0, At, B0); PG8_MMA(0, 1, At, B1); PG8_BAR; PG8_SCHED;
            PG8_LDA(At, 1, 1); PG8_STAGE(PG8_SB(1, 0), b3, voffB); PG8_STAGE(PG8_SB(1, 1), b3 + hstep, voffB); PG8_STAGE(PG8_SA(1, 0), a3, voffA);
            PG8_WAIT_V(8); PG8_WAIT_L(0); PG8_BAR; PG8_MMA(1, 0, At, B0); PG8_MMA(1, 1, At, B1); PG8_BAR; PG8_SCHED;
            } else {
            PG8_LDB(B0, 0, 0); PG8_SCHED; PG8_LDA(At, 0, 0); PG8_STAGE(PG8_SA(1, 1), a1 + hstep, voffA);
            PG8_WAIT_L(8); PG8_BAR; PG8_WAIT_L(0); PG8_MMA(0, 0, At, B0); PG8_BAR; PG8_SCHED;
            PG8_LDB(B1, 0, 1); PG8_STAGE(PG8_SB(0, 0), b2, voffB);
            PG8_BAR; PG8_WAIT_L(0); PG8_MMA(0, 1, At, B1); PG8_BAR;
            PG8_LDA(At, 0, 1); PG8_STAGE(PG8_SA(0, 0), a2, voffA);
            PG8_BAR; PG8_WAIT_L(0); PG8_MMA(1, 0, At, B0); PG8_BAR; PG8_SCHED;
            PG8_STAGE(PG8_SB(0, 1), b2 + hstep, voffB);
            PG8_WAIT_V(6); PG8_BAR; PG8_MMA(1, 1, At, B1); PG8_BAR;
            PG8_LDB(B0, 1, 0); PG8_SCHED; PG8_LDA(At, 1, 0); PG8_STAGE(PG8_SA(0, 1), a2 + hstep, voffA);
            PG8_WAIT_L(8); PG8_BAR; PG8_WAIT_L(0); PG8_MMA(0, 0, At, B0); PG8_BAR; PG8_SCHED;
            PG8_LDB(B1, 1, 1); PG8_STAGE(PG8_SB(1, 0), b3, voffB);
            PG8_BAR; PG8_WAIT_L(0); PG8_MMA(0, 1, At, B1); PG8_BAR;
            PG8_LDA(At, 1, 1); PG8_STAGE(PG8_SA(1, 0), a3, voffA);
            PG8_BAR; PG8_WAIT_L(0); PG8_MMA(1, 0, At, B0); PG8_BAR; PG8_SCHED;
            PG8_STAGE(PG8_SB(1, 1), b3 + hstep, voffB);
            PG8_WAIT_V(6); PG8_BAR; PG8_MMA(1, 1, At, B1); PG8_BAR;
            }
        }
        if constexpr (ALIGN_EPI) { if (wr == 0) PG8_BAR; }
        E(acc, cur, wr, wc, fr, fq);
        if (!has_next) break;
#pragma unroll
        for (int a = 0; a < 2; ++a)
#pragma unroll
            for (int b = 0; b < 2; ++b)
#pragma unroll
                for (int m = 0; m < 4; ++m)
#pragma unroll
                    for (int n = 0; n < 2; ++n) acc[a][b][m][n] = acc_t{};
        cur = nxt; cA = nA; cB = nB; ++ui;
        if constexpr (ALIGN_EPI) { if (wr == 1) PG8_BAR; }
    }
    PG8_WAIT_V(0);
    if constexpr (!ALIGN_EPI) { if (wr == 0) PG8_BAR; }
    PG8_BAR;
#undef PG8_SA
#undef PG8_SB
#undef PG8_STAGE
#undef PG8_LDA
#undef PG8_LDB
#undef PG8_MMA
#undef PG8_WAIT_V
#undef PG8_WAIT_L
#undef PG8_BAR
#undef PG8_SCHED
}
}
using pg8::Unit;
typedef const f32x4 (&AccRef)[2][2][4][2];

__device__ __forceinline__ void store8_bf16(bf16_t* p, f32x4 v0, f32x4 v1) {
    u32x4 w; w.x = cvt_pk_bf16(v0[0], v0[1]); w.y = cvt_pk_bf16(v0[2], v0[3]); w.z = cvt_pk_bf16(v1[0], v1[1]); w.w = cvt_pk_bf16(v1[2], v1[3]); *(u32x4*)p = w;
}
__device__ __forceinline__ unsigned long long opaque_u64(unsigned long long v_) { unsigned lo_ = __builtin_amdgcn_readfirstlane((unsigned)v_), hi_ = __builtin_amdgcn_readfirstlane((unsigned)(v_ >> 32));
    asm volatile("" : "+s"(lo_), "+s"(hi_)); return ((unsigned long long)hi_ << 32) | lo_; }
struct EpiA {
    static constexpr bool PERM = true, KHOOK = false;
    unsigned char* ws_; const float* bgate_;
    __device__ __forceinline__ void khook(f32x4 (&)[2][2][4][2], const Unit&, int, int, int, int, int) const {}
    __device__ __forceinline__ void operator()(AccRef acc, const Unit& u, int wr, int wc, int fr, int fq) const {
        const int pn = u.pn, row0 = u.pm * 256 + wr * 64 + fr, ct = wc * 32 + 8 * fq;
        unsigned char* ws = ws_; const float* bgate = bgate_;
        const float* rs = (const float*)(ws + WS_RS);
        if (pn < 12) {
            bf16_t* base = (bf16_t*)(ws + (pn < 4 ? WS_QA : (pn < 8 ? WS_KA : WS_VA))) + (pn & 3) * 256 + ct; const float sc0 = pn < 4 ? NA_SCALE : 1.f;
#pragma unroll
            for (int ai = 0; ai < 2; ++ai)
#pragma unroll
                for (int m = 0; m < 4; ++m) { const int row = row0 + ai * 128 + m * 16; const float sc = rs[row] * sc0;
#pragma unroll
                    for (int bj = 0; bj < 2; ++bj) store8_bf16(base + (size_t)row * 1024 + bj * 128, acc[ai][bj][m][0] * sc, acc[ai][bj][m][1] * sc); }
        } else if (pn < 20) {
            bf16_t* base = (bf16_t*)(ws + WS_ZB) + (pn - 12) * 256 + ct;
#pragma unroll
            for (int ai = 0; ai < 2; ++ai)
#pragma unroll
                for (int m = 0; m < 4; ++m) { const int row = row0 + ai * 128 + m * 16; const float r = rs[row];
#pragma unroll
                    for (int bj = 0; bj < 2; ++bj) { f32x4 v0 = acc[ai][bj][m][0] * r, v1 = acc[ai][bj][m][1] * r;
#pragma unroll
                        for (int i = 0; i < 4; ++i) { v0[i] = gelu_tanh(v0[i]); v1[i] = gelu_tanh(v1[i]); }
                        store8_bf16(base + (size_t)row * 2048 + bj * 128, v0, v1); } }
        } else if (pn < 24) {
            const int half = (pn - 20) & 1; bf16_t* base = (bf16_t*)(ws + (pn < 22 ? WS_CQ : WS_CKV)) + half * 256 + ct; float* ss = (float*)(ws + (pn < 22 ? WS_CQSS : WS_CKVSS)) + half * 4 + wc;
#pragma unroll
            for (int ai = 0; ai < 2; ++ai)
#pragma unroll
                for (int m = 0; m < 4; ++m) { const int row = row0 + ai * 128 + m * 16; const float r = rs[row]; float s = 0.f;
#pragma unroll
                    for (int bj = 0; bj < 2; ++bj) { const f32x4 v0 = acc[ai][bj][m][0] * r, v1 = acc[ai][bj][m][1] * r;
                        s += (v0[0] * v0[0] + v0[1] * v0[1]) + (v0[2] * v0[2] + v0[3] * v0[3]) + (v1[0] * v1[0] + v1[1] * v1[1]) + (v1[2] * v1[2] + v1[3] * v1[3]);
                        store8_bf16(base + (size_t)row * 512 + bj * 128, v0, v1); }
                    s += __shfl_xor(s, 16); s += __shfl_xor(s, 32);
                    if (fq == 0) ss[(size_t)row * 8] = s; }
        } else if (pn < 48) {
            const int c0 = (pn - 24) * 256 + ct; bf16_t* base = (bf16_t*)(ws + WS_GATES) + c0;
            const f32x4 b00 = *(const f32x4*)(bgate + c0), b01 = *(const f32x4*)(bgate + c0 + 4), b10 = *(const f32x4*)(bgate + c0 + 128), b11 = *(const f32x4*)(bgate + c0 + 132);
#pragma unroll
            for (int ai = 0; ai < 2; ++ai)
#pragma unroll
                for (int m = 0; m < 4; ++m) { const int row = row0 + ai * 128 + m * 16; const float r = rs[row];
#pragma unroll
                    for (int bj = 0; bj < 2; ++bj) { f32x4 v0 = acc[ai][bj][m][0] * r + (bj ? b10 : b00), v1 = acc[ai][bj][m][1] * r + (bj ? b11 : b01);
#pragma unroll
                        for (int i = 0; i < 4; ++i) { v0[i] = sigmoidf_(v0[i]); v1[i] = sigmoidf_(v1[i]); }
                        store8_bf16(base + (size_t)row * 6144 + bj * 128, v0, v1); } }
        }
    }
};
__device__ __forceinline__ unsigned q8(float v) { int i = (int)__builtin_rintf(v); i = i < -127 ? -127 : (i > 127 ? 127 : i); return (unsigned)i & 255u; }
__device__ __forceinline__ unsigned pack4_q8(float a, float b, float c, float d) { return q8(a) | (q8(b) << 8) | (q8(c) << 16) | (q8(d) << 24); }
struct EpiA8 {
    static constexpr bool PERM = true, KHOOK = false;
    unsigned char* ws_; const float* bgate_; const float* sb_;
    __device__ __forceinline__ void khook(i32x4_t (&)[2][2][4][2], const Unit&, int, int, int, int, int) const {}
    __device__ __forceinline__ void operator()(const i32x4_t (&acc)[2][2][4][2], const Unit& u, int wr, int wc, int fr, int fq) const {
        unsigned char* ws = (unsigned char*)opaque_u64((unsigned long long)ws_); const float* bgate = (const float*)opaque_u64((unsigned long long)bgate_); const float* sb = (const float*)opaque_u64((unsigned long long)sb_);
        const float* rs = (const float*)(ws + WS_RS); const float* sa = (const float*)(ws + WS_SA);
        const int pn = u.pn, row0 = u.pm * 256 + wr * 64 + fr, ct = wc * 32 + 8 * fq;
        f32x4 ss[2][2];
#pragma unroll
        for (int bj = 0; bj < 2; ++bj)
#pragma unroll
            for (int n = 0; n < 2; ++n) ss[bj][n] = *(const f32x4*)(sb + pn * 256 + ct + bj * 128 + 4 * n);
#define A8F(ai, bj, m, n) __builtin_convertvector(acc[ai][bj][m][n], f32x4)
        if (pn < 12) {
            bf16_t* base = (bf16_t*)(ws + (pn < 4 ? WS_QA : (pn < 8 ? WS_KA : WS_VA))) + (pn & 3) * 256 + ct; const float sc0 = pn < 4 ? NA_SCALE : 1.f;
#pragma unroll
            for (int ai = 0; ai < 2; ++ai)
#pragma unroll
                for (int m = 0; m < 4; ++m) { const int row = row0 + ai * 128 + m * 16; const float sc = rs[row] * sa[row] * sc0;
#pragma unroll
                    for (int bj = 0; bj < 2; ++bj) store8_bf16(base + (size_t)row * 1024 + bj * 128, A8F(ai, bj, m, 0) * (ss[bj][0] * sc), A8F(ai, bj, m, 1) * (ss[bj][1] * sc)); }
        } else if (pn < 20) {
            bf16_t* base = (bf16_t*)(ws + WS_ZB) + (pn - 12) * 256 + ct; float* zst = (float*)(ws + WS_ZST) + ((pn - 16) & 3) * 8 + wc * 2;
#pragma unroll
            for (int ai = 0; ai < 2; ++ai)
#pragma unroll
                for (int m = 0; m < 4; ++m) { const int row = row0 + ai * 128 + m * 16; const float r = rs[row] * sa[row]; float s1 = 0.f, s2 = 0.f;
#pragma unroll
                    for (int bj = 0; bj < 2; ++bj) { f32x4 v0 = A8F(ai, bj, m, 0) * (ss[bj][0] * r), v1 = A8F(ai, bj, m, 1) * (ss[bj][1] * r);
#pragma unroll
                        for (int i = 0; i < 4; ++i) { v0[i] = gelu_tanh(v0[i]); v1[i] = gelu_tanh(v1[i]); }
                        s1 += ((v0[0] + v0[1]) + (v0[2] + v0[3])) + ((v1[0] + v1[1]) + (v1[2] + v1[3]));
                        s2 += ((v0[0] * v0[0] + v0[1] * v0[1]) + (v0[2] * v0[2] + v0[3] * v0[3])) + ((v1[0] * v1[0] + v1[1] * v1[1]) + (v1[2] * v1[2] + v1[3] * v1[3]));
                        store8_bf16(base + (size_t)row * 2048 + bj * 128, v0, v1); }
                    if (pn >= 16) { s1 += __shfl_xor(s1, 16); s1 += __shfl_xor(s1, 32); s2 += __shfl_xor(s2, 16); s2 += __shfl_xor(s2, 32);
                        if (fq == 0) *(f32x2*)(zst + (size_t)row * 32) = (f32x2){s1, s2}; } }
        } else if (pn < 24) {
            const int half = (pn - 20) & 1; bf16_t* base = (bf16_t*)(ws + (pn < 22 ? WS_CQ : WS_CKV)) + half * 256 + ct; float* sq = (float*)(ws + (pn < 22 ? WS_CQSS : WS_CKVSS)) + half * 4 + wc;
#pragma unroll
            for (int ai = 0; ai < 2; ++ai)
#pragma unroll
                for (int m = 0; m < 4; ++m) { const int row = row0 + ai * 128 + m * 16; const float r = rs[row] * sa[row]; float s = 0.f;
#pragma unroll
                    for (int bj = 0; bj < 2; ++bj) { const f32x4 v0 = A8F(ai, bj, m, 0) * (ss[bj][0] * r), v1 = A8F(ai, bj, m, 1) * (ss[bj][1] * r);
                        s += (v0[0] * v0[0] + v0[1] * v0[1]) + (v0[2] * v0[2] + v0[3] * v0[3]) + (v1[0] * v1[0] + v1[1] * v1[1]) + (v1[2] * v1[2] + v1[3] * v1[3]);
                        store8_bf16(base + (size_t)row * 512 + bj * 128, v0, v1); }
                    s += __shfl_xor(s, 16); s += __shfl_xor(s, 32);
                    if (fq == 0) sq[(size_t)row * 8] = s; }
        } else {
            const int c0 = (pn - 24) * 256 + ct; bf16_t* base = (bf16_t*)(ws + WS_GATES) + c0;
            f32x4 bb[2][2];
#pragma unroll
            for (int bj = 0; bj < 2; ++bj)
#pragma unroll
                for (int n = 0; n < 2; ++n) bb[bj][n] = *(const f32x4*)(bgate + c0 + bj * 128 + 4 * n);
#pragma unroll
            for (int ai = 0; ai < 2; ++ai)
#pragma unroll
                for (int m = 0; m < 4; ++m) { const int row = row0 + ai * 128 + m * 16; const float r = rs[row] * sa[row];
#pragma unroll
                    for (int bj = 0; bj < 2; ++bj) { f32x4 v0 = A8F(ai, bj, m, 0) * (ss[bj][0] * r) + bb[bj][0], v1 = A8F(ai, bj, m, 1) * (ss[bj][1] * r) + bb[bj][1];
#pragma unroll
                        for (int i = 0; i < 4; ++i) { v0[i] = sigmoidf_(v0[i]); v1[i] = sigmoidf_(v1[i]); }
                        store8_bf16(base + (size_t)row * 6144 + bj * 128, v0, v1); } }
        }
#undef A8F
    }
};
struct EpiQup; struct EpiKVup;
struct EpiQup {
    static constexpr bool PERM = true, KHOOK = false;
    const float* ss; const f32x2* rope; bf16_t* QF;
    __device__ __forceinline__ void khook(f32x4 (&)[2][2][4][2], const Unit&, int, int, int, int, int) const {}
    __device__ __forceinline__ void operator()(AccRef acc, const Unit& u, int wr, int wc, int fr, int fq) const {
        const int row0 = u.pm * 256 + wr * 64 + fr, ct = u.pn * 256 + wc * 32 + 8 * fq;
#pragma unroll
        for (int ai = 0; ai < 2; ++ai)
#pragma unroll
            for (int m = 0; m < 4; ++m) {
                const int row = row0 + ai * 128 + m * 16;
                const f32x4 s0 = *(const f32x4*)(ss + (size_t)row * 8), s1 = *(const f32x4*)(ss + (size_t)row * 8 + 4);
                const float r = rsqrtf(((s0[0] + s0[1]) + (s0[2] + s0[3]) + (s1[0] + s1[1]) + (s1[2] + s1[3])) * (1.f / 512.f) + EPS);
#pragma unroll
                for (int bj = 0; bj < 2; ++bj) { const int col = ct + bj * 128, off = col % 192; f32x4 v0 = acc[ai][bj][m][0] * r, v1 = acc[ai][bj][m][1] * r;
                    if (off >= 128) { const int i0 = (off - 128) >> 1; const f32x2* rp = rope + (size_t)(row & (SEQ - 1)) * 32 + i0;
                        const f32x2 c0 = rp[0], c1 = rp[1], c2 = rp[2], c3 = rp[3];
                        const f32x4 a = v0, b = v1;
                        v0[0] = a[0] * c0.x - a[1] * c0.y; v0[1] = a[1] * c0.x + a[0] * c0.y; v0[2] = a[2] * c1.x - a[3] * c1.y; v0[3] = a[3] * c1.x + a[2] * c1.y;
                        v1[0] = b[0] * c2.x - b[1] * c2.y; v1[1] = b[1] * c2.x + b[0] * c2.y; v1[2] = b[2] * c3.x - b[3] * c3.y; v1[3] = b[3] * c3.x + b[2] * c3.y; }
                    store8_bf16(QF + (size_t)row * 1536 + col, v0, v1); }
            }
    }
};
struct EpiKVup {
    static constexpr bool PERM = true, KHOOK = false;
    const float* ss; bf16_t *KF, *VF;
    __device__ __forceinline__ void khook(f32x4 (&)[2][2][4][2], const Unit&, int, int, int, int, int) const {}
    __device__ __forceinline__ void operator()(AccRef acc, const Unit& u, int wr, int wc, int fr, int fq) const {
        const int row0 = u.pm * 256 + wr * 64 + fr, ct = wc * 32 + 8 * fq, h = u.pn;
#pragma unroll
        for (int ai = 0; ai < 2; ++ai)
#pragma unroll
            for (int m = 0; m < 4; ++m) {
                const int row = row0 + ai * 128 + m * 16;
                const f32x4 s0 = *(const f32x4*)(ss + (size_t)row * 8), s1 = *(const f32x4*)(ss + (size_t)row * 8 + 4);
                const float r = rsqrtf(((s0[0] + s0[1]) + (s0[2] + s0[3]) + (s1[0] + s1[1]) + (s1[2] + s1[3])) * (1.f / 512.f) + EPS);
                store8_bf16(KF + (size_t)row * 1536 + h * 192 + ct, acc[ai][0][m][0] * r, acc[ai][0][m][1] * r);
                store8_bf16(VF + (size_t)row * 1024 + h * 128 + ct, acc[ai][1][m][0] * r, acc[ai][1][m][1] * r);
            }
    }
};
struct EpiUp {
    static constexpr bool PERM = true, KHOOK = false;
    EpiQup q; EpiKVup kv;
    __device__ __forceinline__ void khook(f32x4 (&)[2][2][4][2], const Unit&, int, int, int, int, int) const {}
    __device__ __forceinline__ void operator()(AccRef acc, const Unit& u, int wr, int wc, int fr, int fq) const {
        if (u.pn < 6) q(acc, u, wr, wc, fr, fq); else { const Unit u2{u.pm, u.pn - 6}; kv(acc, u2, wr, wc, fr, fq); }
    }
};
struct EpiMerge {
    static constexpr bool PERM = true, KHOOK = true;
    const bf16_t* GATES; bf16_t* MERGED;
    __device__ __forceinline__ void khook(f32x4 (&acc)[2][2][4][2], const Unit& u, int br, int wr, int wc, int fr, int fq) const {
        const bf16_t* gp = GATES + (size_t)(u.pm * 256 + wr * 64 + fr) * 6144 + (br - 1) * 2048 + u.pn * 256 + wc * 32 + 8 * fq;
#pragma unroll
        for (int ai = 0; ai < 2; ++ai)
#pragma unroll
            for (int m = 0; m < 4; ++m)
#pragma unroll
                for (int bj = 0; bj < 2; ++bj) { const bf16_t* q = gp + (size_t)(ai * 128 + m * 16) * 6144 + bj * 128; const u32x4 gp_ = *(const u32x4*)q, gn_ = *(const u32x4*)(q + 2048);
                    f32x4 r0, r1;
                    r0[0] = bf2f(gp_[0] & 0xffffu) * __builtin_amdgcn_rcpf(fmaxf(bf2f(gn_[0] & 0xffffu), 1e-30f)); r0[1] = bf2f(gp_[0] >> 16) * __builtin_amdgcn_rcpf(fmaxf(bf2f(gn_[0] >> 16), 1e-30f));
                    r0[2] = bf2f(gp_[1] & 0xffffu) * __builtin_amdgcn_rcpf(fmaxf(bf2f(gn_[1] & 0xffffu), 1e-30f)); r0[3] = bf2f(gp_[1] >> 16) * __builtin_amdgcn_rcpf(fmaxf(bf2f(gn_[1] >> 16), 1e-30f));
                    r1[0] = bf2f(gp_[2] & 0xffffu) * __builtin_amdgcn_rcpf(fmaxf(bf2f(gn_[2] & 0xffffu), 1e-30f)); r1[1] = bf2f(gp_[2] >> 16) * __builtin_amdgcn_rcpf(fmaxf(bf2f(gn_[2] >> 16), 1e-30f));
                    r1[2] = bf2f(gp_[3] & 0xffffu) * __builtin_amdgcn_rcpf(fmaxf(bf2f(gn_[3] & 0xffffu), 1e-30f)); r1[3] = bf2f(gp_[3] >> 16) * __builtin_amdgcn_rcpf(fmaxf(bf2f(gn_[3] >> 16), 1e-30f));
                    acc[ai][bj][m][0] *= r0; acc[ai][bj][m][1] *= r1;
                    asm volatile("" ::: "memory"); }
    }
    __device__ __forceinline__ void operator()(AccRef acc, const Unit& u, int wr, int wc, int fr, int fq) const {
        const int row0 = u.pm * 256 + wr * 64 + fr, ct = u.pn * 256 + wc * 32 + 8 * fq;
#pragma unroll
        for (int ai = 0; ai < 2; ++ai)
#pragma unroll
            for (int m = 0; m < 4; ++m) { const int row = row0 + ai * 128 + m * 16;
#pragma unroll
                for (int bj = 0; bj < 2; ++bj) { const u32x4 g = *(const u32x4*)(GATES + (size_t)row * 6144 + 4096 + ct + bj * 128);
                    f32x4 v0 = acc[ai][bj][m][0], v1 = acc[ai][bj][m][1];
                    v0[0] *= fmaxf(bf2f(g[0] & 0xffffu), 1e-30f); v0[1] *= fmaxf(bf2f(g[0] >> 16), 1e-30f); v0[2] *= fmaxf(bf2f(g[1] & 0xffffu), 1e-30f); v0[3] *= fmaxf(bf2f(g[1] >> 16), 1e-30f);
                    v1[0] *= fmaxf(bf2f(g[2] & 0xffffu), 1e-30f); v1[1] *= fmaxf(bf2f(g[2] >> 16), 1e-30f); v1[2] *= fmaxf(bf2f(g[3] & 0xffffu), 1e-30f); v1[3] *= fmaxf(bf2f(g[3] >> 16), 1e-30f);
                    store8_bf16(MERGED + (size_t)row * 2048 + ct + bj * 128, v0, v1); }
                asm volatile("" ::: "memory"); }
    }
};
template <bool B16> struct EpiOutT {
    static constexpr bool PERM = true, KHOOK = false;
    const float* base; bf16_t* XB; float* XSS;
    __device__ __forceinline__ void khook(f32x4 (&)[2][2][4][2], const Unit&, int, int, int, int, int) const {}
    __device__ __forceinline__ void operator()(AccRef acc, const Unit& u, int wr, int wc, int fr, int fq) const {
        const int row0 = u.pm * 256 + wr * 64 + fr, col0 = u.pn * 256 + wc * 32 + 8 * fq;
#pragma unroll
        for (int ai = 0; ai < 2; ++ai)
#pragma unroll
            for (int m = 0; m < 4; ++m) { const int row = row0 + ai * 128 + m * 16; const size_t off = (size_t)row * DM + col0; float s = 0.f;
#pragma unroll
                for (int bj = 0; bj < 2; ++bj) { f32x4 b0, b1;
                    if constexpr (B16) { const u32x4 w = *(const u32x4*)(XB + off + bj * 128); b0 = (f32x4){bf2f(w.x & 0xffffu), bf2f(w.x >> 16), bf2f(w.y & 0xffffu), bf2f(w.y >> 16)}; b1 = (f32x4){bf2f(w.z & 0xffffu), bf2f(w.z >> 16), bf2f(w.w & 0xffffu), bf2f(w.w >> 16)}; }
                    else { b0 = *(const f32x4*)(base + off + bj * 128); b1 = *(const f32x4*)(base + off + bj * 128 + 4); }
                    const f32x4 v0 = b0 + acc[ai][bj][m][0], v1 = b1 + acc[ai][bj][m][1];
                    store8_bf16(XB + off + bj * 128, v0, v1);
                    s += ((v0[0] * v0[0] + v0[1] * v0[1]) + (v0[2] * v0[2] + v0[3] * v0[3])) + ((v1[0] * v1[0] + v1[1] * v1[1]) + (v1[2] * v1[2] + v1[3] * v1[3])); }
                s += __shfl_xor(s, 16); s += __shfl_xor(s, 32);
                if (fq == 0) XSS[(size_t)row * 32 + u.pn * 4 + wc] = s; }
    }
};
struct EpiQuery {
    static constexpr bool PERM = true, KHOOK = false;
    const float* XSS; float* SC; float* RS2;
    __device__ __forceinline__ void khook(f32x4 (&)[2][2][4][2], const Unit&, int, int, int, int, int) const {}
    __device__ __forceinline__ void operator()(AccRef acc, const Unit& u, int wr, int wc, int fr, int fq) const {
        const int row0 = u.pm * 256 + wr * 64 + fr, ct = u.pn * 256 + wc * 32 + 8 * fq;
#pragma unroll
        for (int ai = 0; ai < 2; ++ai)
#pragma unroll
            for (int m = 0; m < 4; ++m) { const int row = row0 + ai * 128 + m * 16; float s = 0.f;
#pragma unroll
                for (int j = 0; j < 8; ++j) { const f32x4 v = *(const f32x4*)(XSS + (size_t)row * 32 + 4 * j); s += (v[0] + v[1]) + (v[2] + v[3]); }
                const float r = rsqrtf(s * (1.f / DM) + EPS);
                if (u.pn == 0 && wc == 0 && fq == 0) RS2[row] = r;
#pragma unroll
                for (int bj = 0; bj < 2; ++bj) store8_bf16((bf16_t*)SC + (size_t)row * 2048 + ct + bj * 128, acc[ai][bj][m][0] * r, acc[ai][bj][m][1] * r); }
    }
};

__device__ __forceinline__ void convert_item(const float* src, bf16_t* dst, const float* scale, int lane) {
#pragma unroll
    for (int j = 0; j < 4; ++j) { const int e = (j * 64 + lane) * 8; f32x4 a = *(const f32x4*)(src + e), b = *(const f32x4*)(src + e + 4);
        if (scale) { a = a * *(const f32x4*)(scale + e); b = b * *(const f32x4*)(scale + e + 4); }
        store8_bf16(dst + e, a, b); }
}

__device__ __forceinline__ void convert_item_hilo(const float* src, bf16_t* dhi, bf16_t* dlo, int lane) {
#pragma unroll
    for (int j = 0; j < 4; ++j) { const int e = (j * 64 + lane) * 8; const f32x4 a = *(const f32x4*)(src + e), b = *(const f32x4*)(src + e + 4);
        u32x4 h; h.x = cvt_pk_bf16(a[0], a[1]); h.y = cvt_pk_bf16(a[2], a[3]); h.z = cvt_pk_bf16(b[0], b[1]); h.w = cvt_pk_bf16(b[2], b[3]); *(u32x4*)(dhi + e) = h;
        f32x4 ra, rb; ra[0] = a[0] - bf2f(h.x & 0xffffu); ra[1] = a[1] - bf2f(h.x >> 16); ra[2] = a[2] - bf2f(h.y & 0xffffu); ra[3] = a[3] - bf2f(h.y >> 16);
        rb[0] = b[0] - bf2f(h.z & 0xffffu); rb[1] = b[1] - bf2f(h.z >> 16); rb[2] = b[2] - bf2f(h.w & 0xffffu); rb[3] = b[3] - bf2f(h.w >> 16);
        store8_bf16(dlo + e, ra, rb); }
}

constexpr float PU_SCALE = 512.f, PV_SCALE = 32.f;
template <int NR> __device__ __forceinline__ void convert_rows_fp8(const float* src, unsigned char* dst, const float* scale, float scl, int lane) {
    f32x4 a[NR][8];
#pragma unroll
    for (int r = 0; r < NR; ++r)
#pragma unroll
        for (int j = 0; j < 2; ++j)
#pragma unroll
            for (int q = 0; q < 4; ++q) a[r][j * 4 + q] = *(const f32x4*)(src + (size_t)r * DM + j * 1024 + lane * 16 + 4 * q);
    f32x4 sc[8];
#pragma unroll
    for (int j = 0; j < 2; ++j)
#pragma unroll
        for (int q = 0; q < 4; ++q) sc[j * 4 + q] = scale ? *(const f32x4*)(scale + j * 1024 + lane * 16 + 4 * q) * scl : (f32x4){scl, scl, scl, scl};
#pragma unroll
    for (int r = 0; r < NR; ++r)
#pragma unroll
        for (int j = 0; j < 2; ++j) { u32x4 w;
#pragma unroll
            for (int q = 0; q < 4; ++q) { const f32x4 v = a[r][j * 4 + q] * sc[j * 4 + q]; unsigned p = 0; p = __builtin_amdgcn_cvt_pk_fp8_f32(v[0], v[1], p, false); p = __builtin_amdgcn_cvt_pk_fp8_f32(v[2], v[3], p, true); w[q] = p; }
            *(u32x4*)(dst + (size_t)r * DM + j * 1024 + lane * 16) = w; }
}
struct TrJob { const float* W; const float* scale; bf16_t* WT; int ldw, c0, ncols, r0, ldt, koff, map, item; };
__device__ __forceinline__ int colmap_rt(int map, int n) {
    if (map == 1) { const int h = n / 192, o = n % 192; if (o < 128) return n; const int j = o - 128; return h * 192 + 128 + (j >> 1) + 32 * (j & 1); }
    if (map == 2) return (n >> 1) + 32 * (n & 1);
    return n;
}
__device__ __forceinline__ void tr_load(const TrJob& J, int lane, float (&v)[32]) {
    const int nblk = J.ncols / 32, kb = J.item / nblk, nb = J.item % nblk, k0 = 64 * kb, n0 = 32 * nb;
    const int sc = J.c0 + colmap_rt(J.map, n0 + (lane & 31));
    const float* p = J.W + (size_t)(k0 + (lane >> 5)) * J.ldw + sc;
#pragma unroll
    for (int i = 0; i < 32; ++i) v[i] = p[(size_t)(2 * i) * J.ldw];
}
__device__ __forceinline__ void tr_store(const TrJob& J, int lane, LAS float* scr, const float (&v)[32]) {
    const int nblk = J.ncols / 32, kb = J.item / nblk, nb = J.item % nblk, k0 = 64 * kb, n0 = 32 * nb;
#pragma unroll
    for (int i = 0; i < 32; ++i) { const int kk = 2 * i + (lane >> 5); scr[kk * 33 + (lane & 31)] = J.scale ? v[i] * J.scale[k0 + kk] : v[i]; }
    asm volatile("s_waitcnt lgkmcnt(0)" ::: "memory");
    const int c = lane & 7;
#pragma unroll
    for (int j = 0; j < 4; ++j) { const int n = (lane >> 3) + 8 * j; const LAS float* s_ = scr + (8 * c) * 33 + n;
        u32x4 o; o.x = cvt_pk_bf16(s_[0 * 33], s_[1 * 33]); o.y = cvt_pk_bf16(s_[2 * 33], s_[3 * 33]); o.z = cvt_pk_bf16(s_[4 * 33], s_[5 * 33]); o.w = cvt_pk_bf16(s_[6 * 33], s_[7 * 33]);
        *(u32x4*)(J.WT + (size_t)(J.r0 + n0 + n) * J.ldt + J.koff + k0 + 8 * c) = o; }
    asm volatile("s_waitcnt lgkmcnt(0)" ::: "memory");
}

struct Args {
    const float* in[25]; float* out; unsigned char* ws; int ph_lo, ph_hi, layer, pad;
};
constexpr int TR_I1 = 0  , TR_I2 = 0  , TR_I3 = 32 * 2, TR_I4 = 8 * 48, TR_I5 = 8 * 64, TR_I6 = 16 * 64, TR_I9 = 32 * 64, TR_I10 = 0  ;
constexpr int TR_NIT = TR_I1 + TR_I2 + TR_I3 + TR_I4 + TR_I5 + 3 * TR_I6 + TR_I9 + TR_I10;
__device__ __forceinline__ TrJob tr_job(const Args& a, int l, unsigned char* wl, int it) {
    bf16_t* WA = (bf16_t*)(wl + WO_WA); const float* n1g = a.in[1] + l * DM;
    int r = it;
    if (r < TR_I1) return TrJob{a.in[2] + (size_t)l * DM * INC, n1g, WA, INC, 0, 6144, 0, DM, 0, 0, r}; r -= TR_I1;
    if (r < TR_I2) return TrJob{a.in[15] + (size_t)l * DM * 6144, n1g, WA, 6144, 0, 6144, 6144, DM, 0, 0, r}; r -= TR_I2;
    if (r < TR_I3) return TrJob{a.in[2] + (size_t)l * DM * INC, n1g, WA, INC, 6144, 64, 12288, DM, 0, 2, r}; r -= TR_I3;
    if (r < TR_I4) return TrJob{a.in[10] + (size_t)l * 512 * 1536, a.in[8] + l * 512, (bf16_t*)(wl + WO_WUQ), 1536, 0, 1536, 0, 512, 0, 1, r}; r -= TR_I4;
    if (r < TR_I5) return TrJob{a.in[11] + (size_t)l * 512 * 2048, a.in[9] + l * 512, (bf16_t*)(wl + WO_WUKV), 2048, 0, 2048, 0, 512, 0, 0, r}; r -= TR_I5;
    if (r < 3 * TR_I6) { const int br = r / TR_I6; return TrJob{(br == 0 ? a.in[12] : (br == 1 ? a.in[13] : a.in[14])) + (size_t)l * 1024 * DM, nullptr, (bf16_t*)(wl + WO_WBR), DM, 0, DM, 0, 3072, br * 1024, 0, r % TR_I6}; } r -= 3 * TR_I6;
    if (r < TR_I9) return TrJob{a.in[17] + (size_t)l * DM * DM, nullptr, (bf16_t*)(wl + WO_WOUT), DM, 0, DM, 0, DM, 0, 0, r}; r -= TR_I9;
    return TrJob{a.in[19] + (size_t)l * DM * DM, a.in[18] + l * DM, (bf16_t*)(wl + WO_WQ), DM, 0, DM, 0, DM, 0, 0, r};
}
constexpr int LDS_BYTES = 147456;
constexpr int CW_STRIP = 8192;
constexpr int CW_BAR = 4096;
constexpr int NWAVES = 8;

__device__ __forceinline__ void p0_prologue(const Args& a, LAS unsigned char* lds, int gw, int NGW, int wave, int lane) {
    LAS float* scr = (LAS float*)(lds + wave * 16384);
    unsigned char* ws = a.ws;
    for (int l = 0; l < DEPTH; ++l) {
        unsigned char* wl = ws + WS_W + (size_t)l * WL_STRIDE;
        bf16_t* WA = (bf16_t*)(wl + WO_WA); bf16_t* WUQ = (bf16_t*)(wl + WO_WUQ); bf16_t* WUKV = (bf16_t*)(wl + WO_WUKV); bf16_t* WBR = (bf16_t*)(wl + WO_WBR);
        bf16_t* WOUT = (bf16_t*)(wl + WO_WOUT); bf16_t* WQ = (bf16_t*)(wl + WO_WQ);
        const float* n1g = a.in[1] + l * DM; const float* n2g = a.in[18] + l * DM;
        const float* w_in = a.in[2] + (size_t)l * DM * INC; const float* w_gate = a.in[15] + (size_t)l * DM * 6144;
        {
            constexpr int NIT = TR_NIT; TrJob JA{}, JB{}; float vA[32], vB[32]; int it = gw;
            if (it < NIT) { JA = tr_job(a, l, wl, it); tr_load(JA, lane, vA); }
            while (it < NIT) {
                int nx = it + NGW;
                if (nx < NIT) { JB = tr_job(a, l, wl, nx); tr_load(JB, lane, vB); }
                tr_store(JA, lane, scr, vA);
                it = nx; if (it >= NIT) break;
                nx = it + NGW;
                if (nx < NIT) { JA = tr_job(a, l, wl, nx); tr_load(JA, lane, vA); }
                tr_store(JB, lane, scr, vB);
                it = nx;
            }
        }
        for (int it = gw; it < 192; it += NGW) { u32x4 z = {0u, 0u, 0u, 0u};
#pragma unroll
            for (int j = 0; j < 4; ++j) *(u32x4*)(WA + (size_t)(12352 + it) * DM + (j * 64 + lane) * 8) = z; }
        bf16_t* KLO = (bf16_t*)(wl + WO_KLO); bf16_t* KEYS = (bf16_t*)(wl + WO_KEYS); bf16_t* SGUW = (bf16_t*)(wl + WO_SGUW); bf16_t* PU = (bf16_t*)(wl + WO_PU); bf16_t* PV = (bf16_t*)(wl + WO_PV);
        constexpr int C1 = 64, C3 = 64, NCV = 2 * C1 + C3;
        for (int it = gw; it < NCV; it += NGW) {
            int r = it;
            if (r < C1) { convert_item_hilo(a.in[20] + (size_t)l * 131072 + (size_t)r * 2048, KEYS + (size_t)r * 2048, KLO + (size_t)r * 2048, lane); continue; } r -= C1;
            if (r < C1) { convert_item_hilo(a.in[21] + (size_t)l * 131072 + (size_t)r * 2048, KEYS + 131072 + (size_t)r * 2048, KLO + 131072 + (size_t)r * 2048, lane); continue; } r -= C1;
            convert_item(a.in[6] + (size_t)l * 131072 + (size_t)r * 2048, SGUW + (size_t)r * 2048, nullptr, lane);
        }
        for (int b4 = gw; b4 < NEXP / 2; b4 += NGW) convert_rows_fp8<2>(a.in[22] + ((size_t)l * NEXP + 2 * b4) * DM, (unsigned char*)PU + (size_t)(2 * b4) * DM, n2g, PU_SCALE, lane);
        for (int b4 = gw; b4 < NEXP / 2; b4 += NGW) convert_rows_fp8<2>(a.in[23] + ((size_t)l * NEXP + 2 * b4) * DM, (unsigned char*)PV + (size_t)(2 * b4) * DM, nullptr, PV_SCALE, lane);
    }
    f32x2* rope = (f32x2*)(ws + WS_ROPE);
    for (int it = gw; it < SEQ * 32 / 64; it += NGW) { const int e = it * 64 + lane, s = e >> 5, i = e & 31;
        const float inv = exp2f(-(float)i * (13.287712379549449f / 32.f)); const float ang = (float)s * inv; float sn, cs; sincosf(ang, &sn, &cs); rope[e] = (f32x2){cs, sn}; }
    const float* x = a.in[0]; bf16_t* XB = (bf16_t*)(ws + WS_XB); float* RS = (float*)(ws + WS_RS); unsigned char* XQ = ws + WS_XQ; float* SA = (float*)(ws + WS_SA);
    for (int t = gw; t < T; t += NGW) { float s = 0.f, am = 0.f; f32x4 pv[4], qv[4];
#pragma unroll
        for (int j = 0; j < 4; ++j) { const int e = (j * 64 + lane) * 8; const f32x4 p = *(const f32x4*)(x + (size_t)t * DM + e), q = *(const f32x4*)(x + (size_t)t * DM + e + 4); pv[j] = p; qv[j] = q;
            s += (p[0] * p[0] + p[1] * p[1]) + (p[2] * p[2] + p[3] * p[3]) + (q[0] * q[0] + q[1] * q[1]) + (q[2] * q[2] + q[3] * q[3]); store8_bf16(XB + (size_t)t * DM + e, p, q);
#pragma unroll
            for (int i = 0; i < 4; ++i) am = fmaxf(am, fmaxf(fabsf(p[i]), fabsf(q[i]))); }
        s = wave_sum(s);
#pragma unroll
        for (int o = 1; o < 64; o <<= 1) am = fmaxf(am, __shfl_xor(am, o));
        const float inv = am > 0.f ? 127.f / am : 0.f;
#pragma unroll
        for (int j = 0; j < 4; ++j) { const int e = (j * 64 + lane) * 8; u32x2 w; w.x = pack4_q8(pv[j][0] * inv, pv[j][1] * inv, pv[j][2] * inv, pv[j][3] * inv); w.y = pack4_q8(qv[j][0] * inv, qv[j][1] * inv, qv[j][2] * inv, qv[j][3] * inv);
            *(u32x2*)(XQ + (size_t)t * DM + e) = w; }
        if (lane == 0) { RS[t] = rsqrtf(s * (1.f / DM) + EPS); SA[t] = am * (1.f / 127.f); } }
}
__device__ __forceinline__ void p0_key_fold(const Args& a, int gw, int NGW, int lane) {
    const int n = lane & 15, g = lane >> 4;
    for (int task = gw; task < DEPTH * 16 * 64; task += NGW) {
        const int l = task >> 10, blk = (task >> 6) & 15, h = blk >> 1, side = blk & 1, kq = task & 63;
        unsigned char* wl = a.ws + WS_W + (size_t)l * WL_STRIDE;
        const float* KF32 = (side ? a.in[21] : a.in[20]) + (size_t)l * 131072 + (size_t)h * 128 * 128 + 8 * g;
        bf16_t* WQT = (bf16_t*)(wl + WO_WQ) + (size_t)(h * 256 + side * 128) * DM + kq * 32 + n;
        const float* wq = a.in[19] + (size_t)l * DM * DM + (size_t)(kq * 32 + n) * DM + h * 256 + side * 128 + 8 * g; const float* g2 = a.in[18] + l * DM + kq * 32 + n;
        bf16x8 bq[2][4];
#pragma unroll
        for (int kg = 0; kg < 2; ++kg) { const float sc = g2[16 * kg]; const float* rp = wq + (size_t)(16 * kg) * DM;
#pragma unroll
            for (int ks = 0; ks < 4; ++ks) { const f32x4 p = *(const f32x4*)(rp + 32 * ks) * sc, q = *(const f32x4*)(rp + 32 * ks + 4) * sc;
                u32x4 w; w.x = cvt_pk_bf16(p[0], p[1]); w.y = cvt_pk_bf16(p[2], p[3]); w.z = cvt_pk_bf16(q[0], q[1]); w.w = cvt_pk_bf16(q[2], q[3]); bq[kg][ks] = __builtin_bit_cast(bf16x8, w); } }
#pragma unroll 1
        for (int kt = 0; kt < 8; ++kt) {
            bf16x8 ah[4], al[4];
#pragma unroll
            for (int ks = 0; ks < 4; ++ks) { const float* kp = KF32 + (size_t)(16 * kt + n) * 128 + 32 * ks; const f32x4 p = *(const f32x4*)kp, q = *(const f32x4*)(kp + 4);
                u32x4 hw; hw.x = cvt_pk_bf16(p[0], p[1]); hw.y = cvt_pk_bf16(p[2], p[3]); hw.z = cvt_pk_bf16(q[0], q[1]); hw.w = cvt_pk_bf16(q[2], q[3]);
                u32x4 lw; lw.x = cvt_pk_bf16(p[0] - bf2f(hw.x & 0xffffu), p[1] - bf2f(hw.x >> 16)); lw.y = cvt_pk_bf16(p[2] - bf2f(hw.y & 0xffffu), p[3] - bf2f(hw.y >> 16));
                lw.z = cvt_pk_bf16(q[0] - bf2f(hw.z & 0xffffu), q[1] - bf2f(hw.z >> 16)); lw.w = cvt_pk_bf16(q[2] - bf2f(hw.w & 0xffffu), q[3] - bf2f(hw.w >> 16));
                ah[ks] = __builtin_bit_cast(bf16x8, hw); al[ks] = __builtin_bit_cast(bf16x8, lw); }
#pragma unroll
            for (int kg = 0; kg < 2; ++kg) { f32x4 acc = {0.f, 0.f, 0.f, 0.f};
#pragma unroll
                for (int ks = 0; ks < 4; ++ks) { acc = __builtin_amdgcn_mfma_f32_16x16x32_bf16(ah[ks], bq[kg][ks], acc, 0, 0, 0); acc = __builtin_amdgcn_mfma_f32_16x16x32_bf16(al[ks], bq[kg][ks], acc, 0, 0, 0); }
#pragma unroll
                for (int r = 0; r < 4; ++r) WQT[(size_t)(16 * kt + 4 * g + r) * DM + 16 * kg] = (bf16_t)f2bf(acc[r]); }
        }
    }
}
__device__ __forceinline__ void p0_quant_strips(const Args& a, LAS unsigned char* lds, const int tid, const int G, const int bx) {
    const int lane = tid & 63, wave = __builtin_amdgcn_readfirstlane(tid >> 6), r = lane >> 3, cg = lane & 7;
    unsigned char* ws = a.ws;
    LAS unsigned char* SB_ = lds;
    LAS float* WMAX = (LAS float*)(lds + 131072);
    for (int strip = bx; strip < DEPTH * 2 * 192; strip += G) {
        const int l = strip / 384, wh = (strip / 192) & 1, nb = strip % 192, n0 = 32 * nb, ld = wh ? 6144 : INC, ng = wh * 6144 + n0;
        const float* W = (wh ? a.in[15] + (size_t)l * DM * 6144 : a.in[2] + (size_t)l * DM * INC) + n0 + 4 * cg; const float* g1 = a.in[1] + l * DM;
        f32x4 m = {0.f, 0.f, 0.f, 0.f};
        f32x4 wa[8], wb[8]; float ga[8], gb[8];
#define QS_LOAD(WR, GN, KB) do { const int k0_ = 64 * (KB); _Pragma("unroll") for (int i = 0; i < 8; ++i) { WR[i] = *(const f32x4*)(W + (size_t)(k0_ + 8 * i + r) * ld); GN[i] = g1[k0_ + 8 * i + r]; } } while (0)
#define QS_STASH(WR, GN, KB) do { const int k0_ = 64 * (KB); _Pragma("unroll") for (int i = 0; i < 8; ++i) { const f32x4 v = WR[i] * GN[i]; const int k_ = k0_ + 8 * i + r; \
            m[0] = fmaxf(m[0], fabsf(v[0])); m[1] = fmaxf(m[1], fabsf(v[1])); m[2] = fmaxf(m[2], fabsf(v[2])); m[3] = fmaxf(m[3], fabsf(v[3])); \
            *(LAS u32x2*)(SB_ + k_ * 64 + ((cg ^ (k_ & 7)) * 8)) = (u32x2){cvt_pk_bf16(v[0], v[1]), cvt_pk_bf16(v[2], v[3])}; } } while (0)
        QS_LOAD(wa, ga, wave); QS_LOAD(wb, gb, wave + 8);
        QS_STASH(wa, ga, wave); QS_LOAD(wa, ga, wave + 16);
        QS_STASH(wb, gb, wave + 8); QS_LOAD(wb, gb, wave + 24);
        QS_STASH(wa, ga, wave + 16);
        QS_STASH(wb, gb, wave + 24);
#undef QS_LOAD
#undef QS_STASH
#pragma unroll
        for (int i = 0; i < 4; ++i) { float v = m[i]; v = fmaxf(v, __shfl_xor(v, 8)); v = fmaxf(v, __shfl_xor(v, 16)); v = fmaxf(v, __shfl_xor(v, 32)); m[i] = v; }
        if (r == 0) *(LAS f32x4*)(WMAX + wave * 32 + 4 * cg) = m;
        __syncthreads();
        const int c = lane & 3;
#pragma unroll
        for (int hf = 0; hf < 2; ++hf) { const int n = (lane >> 2) + 16 * hf; float cmax = WMAX[n];
#pragma unroll
            for (int w_ = 1; w_ < 8; ++w_) cmax = fmaxf(cmax, WMAX[w_ * 32 + n]);
            const float inv = cmax > 0.f ? 127.f / cmax : 0.f; const int cgn = n >> 2, sub = (n & 3) * 2;
#pragma unroll
            for (int kq = 0; kq < 4; ++kq) { const int kb = wave + 8 * kq, kbase = 64 * kb + 16 * c; u32x4 o;
#pragma unroll
                for (int q = 0; q < 4; ++q) { float f[4];
#pragma unroll
                    for (int e = 0; e < 4; ++e) { const int k_ = kbase + 4 * q + e; f[e] = bf2f((unsigned)*(const LAS unsigned short*)(SB_ + k_ * 64 + ((cgn ^ (k_ & 7)) * 8) + sub)) * inv; }
                    o[q] = pack4_q8(f[0], f[1], f[2], f[3]); }
                *(u32x4*)(ws + WS_WGQ + (size_t)l * 12288 * DM + (size_t)(ng + n) * DM + kbase) = o; }
            if (wave == 0 && c == 0) ((float*)(ws + WS_SB))[l * 12288 + ng + n] = cmax * (1.f / 127.f); }
        __syncthreads();
    }
}
__device__ __forceinline__ void p0_gates_quant(const Args& a, LAS unsigned char* lds, int gw, int NGW, int wave, int lane) {
    LAS float* scr = (LAS float*)(lds + wave * 16384); unsigned char* ws = a.ws;
    constexpr int NIT = DEPTH * 2 * 32 * 192;
    auto mkjob = [](const Args& a_, int it) { const int l = it / (2 * 32 * 192), wh = (it / (32 * 192)) & 1; return TrJob{wh ? a_.in[15] + (size_t)l * DM * 6144 : a_.in[2] + (size_t)l * DM * INC, a_.in[1] + l * DM, nullptr, wh ? 6144 : INC, 0, 6144, l  , DM, wh * 6144  , 0, it % (32 * 192)}; };
    auto qload = [&](const TrJob& J, f32x4 (&w)[8], float (&gn)[8]) {
        const int nblk = J.ncols / 32, kb = J.item / nblk, nb = J.item % nblk, k0 = 64 * kb, n0 = 32 * nb;
        const float* p = J.W + (size_t)(k0 + (lane >> 3)) * J.ldw + n0 + 4 * (lane & 7);
#pragma unroll
        for (int i = 0; i < 8; ++i) { w[i] = *(const f32x4*)(p + (size_t)(8 * i) * J.ldw); gn[i] = J.scale[k0 + 8 * i + (lane >> 3)]; }
    };
    auto store = [&](const TrJob& J, const f32x4 (&w)[8], const float (&gn)[8]) {
        const int nblk = J.ncols / 32, kb = J.item / nblk, nb = J.item % nblk, k0 = 64 * kb, n0 = 32 * nb, l = J.r0, ng = J.koff + n0;
#pragma unroll
        for (int i = 0; i < 8; ++i) { LAS float* sp_ = scr + (8 * i + (lane >> 3)) * 33 + 4 * (lane & 7); const f32x4 v = w[i] * gn[i]; sp_[0] = v[0]; sp_[1] = v[1]; sp_[2] = v[2]; sp_[3] = v[3]; }
        asm volatile("s_waitcnt lgkmcnt(0)" ::: "memory");
        const int c = lane & 3;
#pragma unroll
        for (int hf = 0; hf < 2; ++hf) { const int n = (lane >> 2) + 16 * hf;
            const float cmax = __uint_as_float(__hip_atomic_load((const unsigned*)(ws + WS_CTL + CTL_CMAX) + l * 12288 + ng + n, __ATOMIC_RELAXED, __HIP_MEMORY_SCOPE_AGENT)); const float inv = cmax > 0.f ? 127.f / cmax : 0.f;
            const LAS float* s_ = scr + (16 * c) * 33 + n; u32x4 o;
#pragma unroll
            for (int q = 0; q < 4; ++q) o[q] = pack4_q8(s_[(4 * q) * 33] * inv, s_[(4 * q + 1) * 33] * inv, s_[(4 * q + 2) * 33] * inv, s_[(4 * q + 3) * 33] * inv);
            *(u32x4*)(ws + WS_WGQ + (size_t)l * 12288 * DM + (size_t)(ng + n) * DM + k0 + 16 * c) = o;
            if (kb == 0 && c == 0) ((float*)(ws + WS_SB))[l * 12288 + ng + n] = cmax * (1.f / 127.f); }
        asm volatile("s_waitcnt lgkmcnt(0)" ::: "memory");
    };
    TrJob JA{}, JB{}; f32x4 wA[8], wB[8]; float gA[8], gB[8]; int it = gw;
    if (it < NIT) { JA = mkjob(a, it); qload(JA, wA, gA); }
    while (it < NIT) {
        int nx = it + NGW;
        if (nx < NIT) { JB = mkjob(a, nx); qload(JB, wB, gB); }
        store(JA, wA, gA);
        it = nx; if (it >= NIT) break;
        nx = it + NGW;
        if (nx < NIT) { JA = mkjob(a, nx); qload(JA, wA, gA); }
        store(JB, wB, gB);
        it = nx;
    }
}

enum Phase { PH_P0 = 0, PH_A = 1, PH_B = 2, PH_C = 3, PH_D = 4, PH_E = 5, PH_F = 6, PH_G1 = 7, PH_G2 = 8, PH_N = 9 };
namespace mla {
using s16x4 = __attribute__((ext_vector_type(4))) short;
using f32x16 = __attribute__((ext_vector_type(16))) float;
constexpr int DQ = 192, DV = 128, QBLK = 32, KVBLK = 64, LDQ = 1536, LDK = 1536, LDV = 1024, LDO = 3072;
constexpr int SHM_V = KVBLK * DV * 2, SHM_K = KVBLK * DQ * 2, SHM_ATTN = 2 * SHM_V + 2 * SHM_K + 8 * 64 * 4;
constexpr float THR = 8.f;
#define MKSWZ(row, colB) ((row) * 384 + ((colB) ^ (((row) & 7) << 4)))
#define MSBAR() __builtin_amdgcn_sched_barrier(0)
__device__ __forceinline__ int crow(int r, int hi) { return (r & 3) + 8 * (r >> 2) + 4 * hi; }
__device__ __forceinline__ void partialSM(f32x16& p0, f32x16& p1, float& m_reg, float& mn, float& alpha) {
  constexpr float C = MLA_SCALE * 1.4426950408889634f;
  float pmax = p0[0];
#pragma unroll
  for (int r = 1; r < 16; ++r) pmax = fmaxf(pmax, p0[r]);
#pragma unroll
  for (int r = 0; r < 16; ++r) pmax = fmaxf(pmax, p1[r]);
  { auto rr = __builtin_amdgcn_permlane32_swap(__float_as_uint(pmax), __float_as_uint(pmax), false, false); pmax = fmaxf(__uint_as_float(rr[0]), __uint_as_float(rr[1])); }
  if (__builtin_expect(__all(pmax - m_reg <= THR / MLA_SCALE), 1)) { mn = m_reg; alpha = 1.f; }
  else { mn = fmaxf(m_reg, pmax); alpha = __builtin_amdgcn_exp2f((m_reg - mn) * C); m_reg = mn; }
  const float mnC = -mn * C;
#pragma unroll
  for (int r = 0; r < 16; ++r) p0[r] = fmaf(p0[r], C, mnC);
#pragma unroll
  for (int r = 0; r < 16; ++r) p1[r] = fmaf(p1[r], C, mnC);
#pragma unroll
  for (int r = 0; r < 16; ++r) p0[r] = __builtin_amdgcn_exp2f(p0[r]);
}
__device__ __forceinline__ void finishSM(f32x16& p0, f32x16& p1, float alpha, float& l_reg, bf16x8& pa0, bf16x8& pa1, bf16x8& pa2, bf16x8& pa3) {
#pragma unroll
  for (int r = 0; r < 16; ++r) p1[r] = __builtin_amdgcn_exp2f(p1[r]);
  float ps = 0;
#pragma unroll
  for (int r = 0; r < 16; ++r) ps += p0[r];
#pragma unroll
  for (int r = 0; r < 16; ++r) ps += p1[r];
  { auto rr = __builtin_amdgcn_permlane32_swap(__float_as_uint(ps), __float_as_uint(ps), false, false); ps = __uint_as_float(rr[0]) + __uint_as_float(rr[1]); }
  l_reg = l_reg * alpha + ps;
#define MPK4(P, BASE, OUT) do { unsigned a0 = cvt_pk_bf16(P[BASE + 0], P[BASE + 1]), a1 = cvt_pk_bf16(P[BASE + 2], P[BASE + 3]);   \
    unsigned b0 = cvt_pk_bf16(P[BASE + 4], P[BASE + 5]), b1 = cvt_pk_bf16(P[BASE + 6], P[BASE + 7]);                              \
    auto r0 = __builtin_amdgcn_permlane32_swap(a0, b0, false, false); auto r1 = __builtin_amdgcn_permlane32_swap(a1, b1, false, false); \
    u32x4 w = {r0[0], r1[0], r0[1], r1[1]}; OUT = __builtin_bit_cast(bf16x8, w); } while (0)
  MPK4(p0, 0, pa0); MPK4(p0, 8, pa1); MPK4(p1, 0, pa2); MPK4(p1, 8, pa3);
#undef MPK4
}
__device__ __forceinline__ void qkt(f32x16& p0, f32x16& p1, const LAS unsigned char* Ks, const bf16x8* qr, int r32, int hi) {
  p0 = f32x16{}; p1 = f32x16{};
#pragma unroll
  for (int d0 = 0; d0 < 12; ++d0) { const int cb = (d0 * 16 + hi * 8) * 2;
    const bf16x8 b0 = *(const LAS bf16x8*)(Ks + MKSWZ(r32, cb));
    const bf16x8 b1 = *(const LAS bf16x8*)(Ks + MKSWZ(32 + r32, cb));
    p0 = __builtin_amdgcn_mfma_f32_32x32x16_bf16(b0, qr[d0], p0, 0, 0, 0);
    p1 = __builtin_amdgcn_mfma_f32_32x32x16_bf16(b1, qr[d0], p1, 0, 0, 0); }
}
__device__ __forceinline__ int v_st(int k, int c) { const int kk = (k & ~0xC) | ((k & 4) << 1) | ((k & 8) >> 1); return ((kk >> 3) * 4 + (c >> 5)) * 512 + ((kk & 7) * 32 + (c & 31)) * 2; }
__device__ __forceinline__ int v_rd_base(int lane) { return ((lane & 3) << 3) | (((lane >> 2) & 3) << 6) | (((lane >> 4) & 1) << 5) | (((lane >> 5) & 1) << 8); }
constexpr int v_rd_off(int d0, int ks, int half) { return d0 * 512 + ks * 4096 + half * 2048; }
template <int OFF> __device__ __forceinline__ s16x4 tr_read(int vb) { s16x4 r; asm volatile("ds_read_b64_tr_b16 %0, %1 offset:%2" : "=&v"(r) : "v"(vb), "i"(OFF) : "memory"); return r; }
template <int D0> __device__ __forceinline__ void pv_one(f32x16& od, int vb, bf16x8 pa0, bf16x8 pa1, bf16x8 pa2, bf16x8 pa3) {
  const s16x4 l0 = tr_read<v_rd_off(D0, 0, 0)>(vb), h0 = tr_read<v_rd_off(D0, 0, 1)>(vb), l1 = tr_read<v_rd_off(D0, 1, 0)>(vb), h1 = tr_read<v_rd_off(D0, 1, 1)>(vb);
  const s16x4 l2 = tr_read<v_rd_off(D0, 2, 0)>(vb), h2 = tr_read<v_rd_off(D0, 2, 1)>(vb), l3 = tr_read<v_rd_off(D0, 3, 0)>(vb), h3 = tr_read<v_rd_off(D0, 3, 1)>(vb);
  asm volatile("s_waitcnt lgkmcnt(0)" ::: "memory"); MSBAR();
#define MPK(L, H) (bf16x8){L[0], L[1], L[2], L[3], H[0], H[1], H[2], H[3]}
  od = __builtin_amdgcn_mfma_f32_32x32x16_bf16(pa0, MPK(l0, h0), od, 0, 0, 0);
  od = __builtin_amdgcn_mfma_f32_32x32x16_bf16(pa1, MPK(l1, h1), od, 0, 0, 0);
  od = __builtin_amdgcn_mfma_f32_32x32x16_bf16(pa2, MPK(l2, h2), od, 0, 0, 0);
  od = __builtin_amdgcn_mfma_f32_32x32x16_bf16(pa3, MPK(l3, h3), od, 0, 0, 0);
#undef MPK
}
__device__ __forceinline__ void pv_d0(f32x16* o, int vb, bf16x8 pa0, bf16x8 pa1, bf16x8 pa2, bf16x8 pa3) {
  pv_one<0>(o[0], vb, pa0, pa1, pa2, pa3); pv_one<1>(o[1], vb, pa0, pa1, pa2, pa3); pv_one<2>(o[2], vb, pa0, pa1, pa2, pa3); pv_one<3>(o[3], vb, pa0, pa1, pa2, pa3);
}
__device__ __forceinline__ void attn_unit(const int tid, const bf16_t* __restrict__ Qb, const bf16_t* __restrict__ Kh, const bf16_t* __restrict__ Vh, bf16_t* __restrict__ Ob, int seq, LAS unsigned char* lds) {
  const int wid = __builtin_amdgcn_readfirstlane(tid >> 6), lane = tid & 63, r32 = lane & 31, hi = lane >> 5;
  LAS unsigned char* V_lds = lds; LAS unsigned char* K_lds = lds + 2 * SHM_V;
  LAS float* ws = (LAS float*)(lds + 2 * SHM_V + 2 * SHM_K) + wid * 64; LAS float* li_l = ws; LAS float* al_l = ws + 32;
  float m_reg = -1e30f, l_reg = 0; f32x16 o[4] = {}; bf16x8 qr[12];
  const bf16_t* Qw = Qb + (size_t)(wid * QBLK + r32) * LDQ + hi * 8;
#pragma unroll
  for (int d0 = 0; d0 < 12; ++d0) qr[d0] = *(const bf16x8*)(Qw + d0 * 16);
  const bf16_t* ksrc[3]; const bf16_t* vsrc[2];
#pragma unroll
  for (int i = 0; i < 3; ++i) { const int p = tid + 512 * i, row = p / 24, d = p % 24; ksrc[i] = Kh + (size_t)row * LDK + ((d ^ (row & 7)) * 8); }
#pragma unroll
  for (int i = 0; i < 2; ++i) { const int p = tid + 512 * i, sub = p >> 5, kk = (sub >> 2) * 8 + ((p & 31) >> 2), c = (sub & 3) * 32 + (p & 3) * 8, k = (kk & ~0xC) | ((kk & 4) << 1) | ((kk & 8) >> 1);
    vsrc[i] = Vh + (size_t)k * LDV + c; }
  const int vb0 = (int)(unsigned)(uintptr_t)V_lds + v_rd_base(lane);
#define MDMA(t, b) do { _Pragma("unroll") for (int i_ = 0; i_ < 3; ++i_) __builtin_amdgcn_global_load_lds((const unsigned*)(ksrc[i_] + (size_t)(t) * KVBLK * LDK), (LAS unsigned*)(K_lds + (b) * SHM_K + (i_ * 8 + wid) * 1024), 16, 0, 0); \
    _Pragma("unroll") for (int i_ = 0; i_ < 2; ++i_) __builtin_amdgcn_global_load_lds((const unsigned*)(vsrc[i_] + (size_t)(t) * KVBLK * LDV), (LAS unsigned*)(V_lds + (b) * SHM_V + (i_ * 8 + wid) * 1024), 16, 0, 0); } while (0)
#define MSWAIT() asm volatile("s_waitcnt vmcnt(0)" ::: "memory")
#define MRESC(a) do { if (__any((a) < 1.f)) { if (hi == 0) al_l[r32] = (a); asm volatile("s_waitcnt lgkmcnt(0)" ::: "memory"); \
    _Pragma("unroll") for (int d = 0; d < 4; ++d) _Pragma("unroll") for (int r = 0; r < 16; ++r) o[d][r] *= al_l[crow(r, hi)]; } } while (0)
  f32x16 p0, p1; float mn, al; bf16x8 pa0, pa1, pa2, pa3; const int NT = seq / KVBLK;
  MDMA(0, 0); MSWAIT(); __syncthreads();
  for (int j = 0; j < NT; ++j) {
    const int buf = j & 1;
    if (j + 1 < NT) MDMA(j + 1, buf ^ 1);
    MSBAR(); qkt(p0, p1, K_lds + buf * SHM_K, qr, r32, hi);
    partialSM(p0, p1, m_reg, mn, al);
    MRESC(al);
    finishSM(p0, p1, al, l_reg, pa0, pa1, pa2, pa3); MSBAR();
    pv_d0(o, vb0 + buf * SHM_V, pa0, pa1, pa2, pa3);
    MSWAIT(); __syncthreads();
  }
  if (hi == 0) li_l[r32] = l_reg; asm volatile("s_waitcnt lgkmcnt(0)" ::: "memory");
  float rli[16];
#pragma unroll
  for (int r = 0; r < 16; ++r) rli[r] = __builtin_amdgcn_rcpf(li_l[crow(r, hi)]);
  bf16_t* Ow = Ob + (size_t)(wid * QBLK) * LDO;
#pragma unroll
  for (int r = 0; r < 16; ++r) { const int orow = crow(r, hi);
#pragma unroll
    for (int d0 = 0; d0 < 4; ++d0) Ow[(size_t)orow * LDO + d0 * 32 + r32] = (bf16_t)f2bf(o[d0][r] * rli[r]); }
  __syncthreads();
#undef MDMA
#undef MSWAIT
#undef MRESC
}
#undef MKSWZ
#undef MSBAR
}
__device__ __forceinline__ void mla_attn_phase(const int tid, unsigned char* ws, LAS unsigned char* lds, int G, int vcu) {
    const bf16_t* QF = (const bf16_t*)(ws + WS_QF); const bf16_t* KF = (const bf16_t*)(ws + WS_KF); const bf16_t* VF = (const bf16_t*)(ws + WS_VF); bf16_t* OCAT = (bf16_t*)(ws + WS_OCAT);
    for (int u = vcu; u < NBATCH * 8 * (SEQ / 256); u += G) { const int bh = u / (SEQ / 256), qb = u % (SEQ / 256), b = bh >> 3, h = bh & 7; const size_t r0 = (size_t)b * SEQ;
        mla::attn_unit(tid, QF + (r0 + qb * 256) * 1536 + h * 192, KF + r0 * 1536 + h * 192, VF + r0 * 1024 + h * 128, OCAT + (r0 + qb * 256) * 3072 + 2048 + h * 128, SEQ, lds); }
}


namespace na {
constexpr int VROW = 288, PROW = 528;
typedef short v4i16_t __attribute__((ext_vector_type(4)));
__device__ __forceinline__ int rho(int j) { return (j & ~0xC) | ((j & 4) << 1) | ((j & 8) >> 1); }
constexpr int L_V = 0, L_P = 256 * VROW, L_WM = L_P + 16 * PROW, L_WL = L_WM + 512, L_BIAS = L_WL + 512, L_END = L_BIAS + 8 * 15 * 31 * 4;
__device__ __forceinline__ void phase(const int tid, unsigned char* ws, const float* bias, LAS unsigned char* lds, int G, int vcu) {
    const bf16_t* QA = (const bf16_t*)(ws + WS_QA); const bf16_t* KA = (const bf16_t*)(ws + WS_KA); const bf16_t* VA = (const bf16_t*)(ws + WS_VA); bf16_t* OCAT = (bf16_t*)(ws + WS_OCAT);
    const int lane = tid & 63, w = __builtin_amdgcn_readfirstlane(tid >> 6), n = lane & 15, g = lane >> 4;
    LAS float* WM = (LAS float*)(lds + L_WM); LAS float* WL = (LAS float*)(lds + L_WL);
    constexpr int NITEM = NBATCH * 8 * 64 * 4; const int PER = (NITEM + G - 1) / G;
    u32x4 vreg[8]; bf16x8 kreg[8], qreg[4];
    LAS float* BL = (LAS float*)(lds + L_BIAS);
    for (int i = tid; i < 8 * 15 * 31; i += 512) BL[i] = bias[i];
    __syncthreads();
#define NA_DECODE(IT) const int cb_ = (IT) & 3, r_ = ((IT) >> 2) & 63, h_ = ((IT) >> 8) & 7, b_ = (IT) >> 11, c0_ = cb_ * 16; \
        int rs_ = r_ - 4; rs_ = rs_ < 0 ? 0 : (rs_ > 56 ? 56 : rs_); int st_ = c0_ - 8; st_ = st_ < 0 ? 0 : (st_ > 32 ? 32 : st_); const size_t tb_ = (size_t)b_ * SEQ
#define NA_FETCH(IT) do { NA_DECODE(IT); \
        _Pragma("unroll") for (int i = 0; i < 8; ++i) { const int id = tid + 512 * i, j = id >> 4, c16 = id & 15; const size_t tok = tb_ + (size_t)(rs_ + (j >> 5)) * GW_ + st_ + (j & 31); \
            vreg[i] = *(const u32x4*)(VA + tok * 1024 + h_ * 128 + c16 * 8); } \
        const size_t tq = tb_ + (size_t)r_ * GW_ + c0_ + n; const bf16_t* qp = QA + tq * 1024 + h_ * 128 + 8 * g; \
        const size_t tk0 = tb_ + (size_t)(rs_ + w) * GW_ + st_ + n; const bf16_t* kp0 = KA + tk0 * 1024 + h_ * 128 + 8 * g; \
        _Pragma("unroll") for (int ks = 0; ks < 4; ++ks) { qreg[ks] = *(const bf16x8*)(qp + 32 * ks); kreg[ks] = *(const bf16x8*)(kp0 + 32 * ks); kreg[4 + ks] = *(const bf16x8*)(kp0 + 16 * 1024 + 32 * ks); } } while (0)
    const int it_lo = vcu * PER, it_hi = (vcu + 1) * PER < NITEM ? (vcu + 1) * PER : NITEM;
    if (it_lo < it_hi) NA_FETCH(it_lo);
    for (int it = it_lo; it < it_hi; ++it) {
        const int cb = it & 3, r = (it >> 2) & 63, h = (it >> 8) & 7, b = it >> 11, c0 = cb * 16;
        int rs = r - 4; rs = rs < 0 ? 0 : (rs > 56 ? 56 : rs);
        int start = c0 - 8; start = start < 0 ? 0 : (start > 32 ? 32 : start);
        const size_t tb = (size_t)b * SEQ;
#pragma unroll
        for (int i = 0; i < 8; ++i) { const int id = tid + 512 * i, j = id >> 4, c16 = id & 15; *(LAS u32x4*)(lds + L_V + rho(j) * VROW + c16 * 16) = vreg[i]; }
        f32x4 acc[2] = {(f32x4){0.f, 0.f, 0.f, 0.f}, (f32x4){0.f, 0.f, 0.f, 0.f}};
#pragma unroll
        for (int ks = 0; ks < 4; ++ks) { acc[0] = __builtin_amdgcn_mfma_f32_16x16x32_bf16(kreg[ks], qreg[ks], acc[0], 0, 0, 0); acc[1] = __builtin_amdgcn_mfma_f32_16x16x32_bf16(kreg[4 + ks], qreg[ks], acc[1], 0, 0, 0); }
        asm volatile("" ::: "memory");
        if (it + 1 < it_hi) NA_FETCH(it + 1);
        const int c = c0 + n; int cs = c - 8; cs = cs < 0 ? 0 : (cs > 48 ? 48 : cs);
        const LAS float* brow = BL + (h * 15 + (rs + w - r + 7)) * 31;
        float sv[8]; float mx = -1e30f;
#pragma unroll
        for (int kt = 0; kt < 2; ++kt)
#pragma unroll
            for (int rg = 0; rg < 4; ++rg) { const int kc = start + 16 * kt + 4 * g + rg; const bool valid = kc >= cs && kc < cs + 16; int dc = kc - c + 15; dc = dc < 0 ? 0 : (dc > 30 ? 30 : dc);
                const float v = valid ? acc[kt][rg] + brow[dc] : -1e30f; sv[kt * 4 + rg] = v; mx = fmaxf(mx, v); }
        mx = fmaxf(mx, __shfl_xor(mx, 16)); mx = fmaxf(mx, __shfl_xor(mx, 32));
        if (g == 0) WM[w * 16 + n] = mx;
        __syncthreads();
        float M = WM[n];
#pragma unroll
        for (int ww = 1; ww < 8; ++ww) M = fmaxf(M, WM[ww * 16 + n]);
        float ls = 0.f;
#pragma unroll
        for (int i = 0; i < 8; ++i) { const float p = sv[i] > -1e29f ? __expf(sv[i] - M) : 0.f; sv[i] = p; ls += p; }
        ls += __shfl_xor(ls, 16); ls += __shfl_xor(ls, 32);
        if (g == 0) WL[w * 16 + n] = ls;
#pragma unroll
        for (int kt = 0; kt < 2; ++kt) { LAS u32x2* pp = (LAS u32x2*)(lds + L_P + n * PROW + (32 * w + 16 * kt + 4 * g) * 2);
            u32x2 pw; pw.x = cvt_pk_bf16(sv[kt * 4 + 0], sv[kt * 4 + 1]); pw.y = cvt_pk_bf16(sv[kt * 4 + 2], sv[kt * 4 + 3]); *pp = pw; }
        __syncthreads();
        f32x4 o = (f32x4){0.f, 0.f, 0.f, 0.f};
#pragma unroll
        for (int ks = 0; ks < 8; ++ks) { const bf16x8 pf = *(const LAS bf16x8*)(lds + L_P + n * PROW + (32 * ks + 8 * g) * 2);
            const int kp = 32 * ks + 8 * g + (n >> 2); const int dcol = (16 * w + 4 * (n & 3)) * 2;
            const v4i16_t t0 = __builtin_amdgcn_ds_read_tr16_b64_v4i16((LAS v4i16_t*)(lds + L_V + rho(kp) * VROW + dcol));
            const v4i16_t t1 = __builtin_amdgcn_ds_read_tr16_b64_v4i16((LAS v4i16_t*)(lds + L_V + rho(kp + 4) * VROW + dcol));
            const bf16x8 vf = (bf16x8){t0[0], t0[1], t0[2], t0[3], t1[0], t1[1], t1[2], t1[3]};
            o = __builtin_amdgcn_mfma_f32_16x16x32_bf16(pf, vf, o, 0, 0, 0); }
#pragma unroll
        for (int rg = 0; rg < 4; ++rg) { const int q = 4 * g + rg; float L = 0.f;
#pragma unroll
            for (int ww = 0; ww < 8; ++ww) L += WL[ww * 16 + q];
            OCAT[(tb + (size_t)r * GW_ + c0 + q) * 3072 + h * 128 + 16 * w + n] = (bf16_t)f2bf(o[rg] / L); }
        __syncthreads();
    }
#undef NA_FETCH
#undef NA_DECODE
}
}


namespace na3 {
constexpr int VP = 288, CHUNK = 32 * VP, L_BIAS = 8 * CHUNK;
typedef short v4i16_t __attribute__((ext_vector_type(4)));
__device__ __forceinline__ void phase(const int tid, unsigned char* ws, const float* bias, LAS unsigned char* lds, int G, int vcu) {
    const bf16_t* QA = (const bf16_t*)(ws + WS_QA); const bf16_t* KA = (const bf16_t*)(ws + WS_KA); const bf16_t* VA = (const bf16_t*)(ws + WS_VA); bf16_t* OCAT = (bf16_t*)(ws + WS_OCAT);
    const int lane = tid & 63, h = __builtin_amdgcn_readfirstlane(tid >> 6), n = lane & 15, g = lane >> 4;
    LAS float* BL = (LAS float*)(lds + L_BIAS);
    for (int i = tid; i < 8 * 15 * 31; i += 512) BL[i] = bias[i];
    __syncthreads();
    LAS unsigned char* vbuf = lds + h * CHUNK;
    const unsigned wroff = (unsigned)((lane >> 4) * VP + (lane & 15) * 16);
    const unsigned rd0 = (unsigned)((4 * g + (n >> 2)) * VP + (n & 3) * 8), rd1 = rd0 + 16u * VP;
    for (int it = vcu; it < NBATCH * 64 * 4; it += G) {
        const int cb = it & 3, r = (it >> 2) & 63, b = it >> 8, c0 = cb * 16;
        int rs = r - 4; rs = rs < 0 ? 0 : (rs > 56 ? 56 : rs);
        int start = c0 - 8; start = start < 0 ? 0 : (start > 32 ? 32 : start);
        const size_t tb = (size_t)b * SEQ;
        bf16x8 qreg[4];
        { const bf16_t* qp = QA + (tb + (size_t)r * GW_ + c0 + n) * 1024 + h * 128 + 8 * g;
#pragma unroll
          for (int ks = 0; ks < 4; ++ks) qreg[ks] = *(const bf16x8*)(qp + 32 * ks); }
        const bf16_t* kbase = KA + (tb + (size_t)rs * GW_ + start + n) * 1024 + h * 128 + 8 * g;
        const bf16_t* vbase = VA + (tb + (size_t)rs * GW_ + start + (lane >> 4)) * 1024 + h * 128 + (lane & 15) * 8;
        u32x4 vreg[8];
#define N3_VLOAD(W) do { _Pragma("unroll") for (int i = 0; i < 8; ++i) vreg[i] = *(const u32x4*)(vbase + (size_t)((W) * GW_ + 4 * i) * 1024); } while (0)
#define N3_KLOAD(KB, T_) do { const bf16_t* kp_ = kbase + (size_t)(((T_) >> 1) * GW_ + 16 * ((T_) & 1)) * 1024; _Pragma("unroll") for (int ks = 0; ks < 4; ++ks) KB[ks] = *(const bf16x8*)(kp_ + 32 * ks); } while (0)
#define N3_KMMA(KB, T_) do { f32x4 a_ = {0.f, 0.f, 0.f, 0.f}; _Pragma("unroll") for (int ks = 0; ks < 4; ++ks) a_ = __builtin_amdgcn_mfma_f32_16x16x32_bf16(KB[ks], qreg[ks], a_, 0, 0, 0); sc[T_] = a_; } while (0)
#define N3_FENCE() asm volatile("" ::: "memory")
        f32x4 sc[16];
        bf16x8 k0[4], k1[4], k2[4], k3[4];
        N3_KLOAD(k0, 0); N3_KLOAD(k1, 1); N3_KLOAD(k2, 2); N3_KLOAD(k3, 3); N3_FENCE();
        N3_KMMA(k0, 0); N3_KLOAD(k0, 4); N3_FENCE();  N3_KMMA(k1, 1); N3_KLOAD(k1, 5); N3_FENCE();  N3_KMMA(k2, 2); N3_KLOAD(k2, 6); N3_FENCE();  N3_KMMA(k3, 3); N3_KLOAD(k3, 7); N3_FENCE();
        N3_KMMA(k0, 4); N3_KLOAD(k0, 8); N3_FENCE();  N3_KMMA(k1, 5); N3_KLOAD(k1, 9); N3_FENCE();  N3_KMMA(k2, 6); N3_KLOAD(k2, 10); N3_FENCE(); N3_KMMA(k3, 7); N3_KLOAD(k3, 11); N3_FENCE();
        N3_KMMA(k0, 8); N3_KLOAD(k0, 12); N3_FENCE(); N3_KMMA(k1, 9); N3_KLOAD(k1, 13); N3_FENCE(); N3_KMMA(k2, 10); N3_KLOAD(k2, 14); N3_FENCE(); N3_KMMA(k3, 11); N3_KLOAD(k3, 15); N3_FENCE();
        N3_VLOAD(0); N3_FENCE();
        N3_KMMA(k0, 12); N3_KMMA(k1, 13); N3_KMMA(k2, 14); N3_KMMA(k3, 15);
        const int c = c0 + n; int cs = c - 8; cs = cs < 0 ? 0 : (cs > 48 ? 48 : cs);
        float mx = -1e30f;
#pragma unroll
        for (int T_ = 0; T_ < 16; ++T_) { const LAS float* brow = BL + (h * 15 + (rs + (T_ >> 1) - r + 7)) * 31;
#pragma unroll
            for (int rg = 0; rg < 4; ++rg) { const int kc = start + 16 * (T_ & 1) + 4 * g + rg; const bool valid = kc >= cs && kc < cs + 16; int dc = kc - c + 15; dc = dc < 0 ? 0 : (dc > 30 ? 30 : dc);
                const float v = valid ? sc[T_][rg] + brow[dc] : -1e30f; sc[T_][rg] = v; mx = fmaxf(mx, v); } }
        mx = fmaxf(mx, __shfl_xor(mx, 16)); mx = fmaxf(mx, __shfl_xor(mx, 32));
        float ls = 0.f;
#pragma unroll
        for (int T_ = 0; T_ < 16; ++T_)
#pragma unroll
            for (int rg = 0; rg < 4; ++rg) { const float p = sc[T_][rg] > -1e29f ? __builtin_amdgcn_exp2f((sc[T_][rg] - mx) * 1.4426950408889634f) : 0.f; sc[T_][rg] = p; ls += p; }
        ls += __shfl_xor(ls, 16); ls += __shfl_xor(ls, 32);
        const float inv = __builtin_amdgcn_rcpf(ls);
        bf16x8 pf[8];
#pragma unroll
        for (int w = 0; w < 8; ++w) { u32x4 pw; pw.x = cvt_pk_bf16(sc[2 * w][0], sc[2 * w][1]); pw.y = cvt_pk_bf16(sc[2 * w][2], sc[2 * w][3]); pw.z = cvt_pk_bf16(sc[2 * w + 1][0], sc[2 * w + 1][1]); pw.w = cvt_pk_bf16(sc[2 * w + 1][2], sc[2 * w + 1][3]);
            pf[w] = __builtin_bit_cast(bf16x8, pw); }
        f32x4 o[8];
#pragma unroll
        for (int dt = 0; dt < 8; ++dt) o[dt] = (f32x4){0.f, 0.f, 0.f, 0.f};
#pragma unroll
        for (int w = 0; w < 8; ++w) {
#pragma unroll
            for (int i = 0; i < 8; ++i) *(LAS u32x4*)(vbuf + wroff + (unsigned)(4 * i) * VP) = vreg[i];
            N3_FENCE();
            if (w + 1 < 8) N3_VLOAD(w + 1);
            asm volatile("s_waitcnt lgkmcnt(0)" ::: "memory");
#pragma unroll
            for (int dt = 0; dt < 8; ++dt) {
                const v4i16_t t0 = __builtin_amdgcn_ds_read_tr16_b64_v4i16((LAS v4i16_t*)(vbuf + rd0 + dt * 32));
                const v4i16_t t1 = __builtin_amdgcn_ds_read_tr16_b64_v4i16((LAS v4i16_t*)(vbuf + rd1 + dt * 32));
                const bf16x8 vf = (bf16x8){t0[0], t0[1], t0[2], t0[3], t1[0], t1[1], t1[2], t1[3]};
                o[dt] = __builtin_amdgcn_mfma_f32_16x16x32_bf16(pf[w], vf, o[dt], 0, 0, 0); }
            asm volatile("s_waitcnt lgkmcnt(0)" ::: "memory");
        }
        float iq[4];
#pragma unroll
        for (int rg = 0; rg < 4; ++rg) iq[rg] = __shfl(inv, 4 * g + rg);
#pragma unroll
        for (int rg = 0; rg < 4; ++rg) { bf16_t* op = OCAT + (tb + (size_t)r * GW_ + c0 + 4 * g + rg) * 3072 + h * 128 + n;
#pragma unroll
            for (int dt = 0; dt < 8; ++dt) op[16 * dt] = (bf16_t)f2bf(o[dt][rg] * iq[rg]); }
#undef N3_VLOAD
#undef N3_KLOAD
#undef N3_KMMA
#undef N3_FENCE
    }
    __syncthreads();
}
}

namespace sgu {
constexpr int VTROW = 288;
constexpr int L_ST = 0, L_VT = 1024, L_END = L_VT + 128 * VTROW;
__device__ __forceinline__ void phase(const int tid, unsigned char* ws, const bf16_t* W, const float* lng, const float* lnb, const float* bs, LAS unsigned char* lds, int G, int vcu) {
    const bf16_t* ZB = (const bf16_t*)(ws + WS_ZB); bf16_t* OCAT = (bf16_t*)(ws + WS_OCAT);
    const int lane = tid & 63, w = __builtin_amdgcn_readfirstlane(tid >> 6), n16 = lane & 15, g4 = lane >> 4;
    LAS f32x2* ST = (LAS f32x2*)(lds + L_ST);
    for (int it = vcu; it < NBATCH * 32 * 8; it += G) {
        const int g = it & 7, nb = it >> 3; const size_t tb = (size_t)nb * 128;
        if (lane < 16) { const int tok = 16 * w + lane; const float* zp = (const float*)(ws + WS_ZST) + (tb + tok) * 32; float s1 = 0.f, s2 = 0.f;
#pragma unroll
            for (int e = 0; e < 8; ++e) { const f32x4 v = *(const f32x4*)(zp + 4 * e); s1 += v[0] + v[2]; s2 += v[1] + v[3]; }
            const float mu = s1 * (1.f / 1024.f), var = fmaxf(s2 * (1.f / 1024.f) - mu * mu, 0.f);
            ST[tok] = (f32x2){mu, rsqrtf(var + EPS)}; }
        __syncthreads();
#pragma unroll
        for (int i = 0; i < 4; ++i) { const int id = tid + 512 * i, q = id & 127, cc = id >> 7; const f32x2 st = ST[q];
            const u32x4 a = *(const u32x4*)(ZB + (tb + q) * 2048 + 1024 + g * 128 + cc * 8);
            const f32x4 g0 = *(const f32x4*)(lng + g * 128 + cc * 8), g1 = *(const f32x4*)(lng + g * 128 + cc * 8 + 4), b0 = *(const f32x4*)(lnb + g * 128 + cc * 8), b1 = *(const f32x4*)(lnb + g * 128 + cc * 8 + 4);
            LAS unsigned short* vt = (LAS unsigned short*)(lds + L_VT + (cc * 8) * VTROW + q * 2);
#pragma unroll
            for (int e = 0; e < 4; ++e) { const float x0 = (bf2f(a[e] & 0xffffu) - st.x) * st.y, x1 = (bf2f(a[e] >> 16) - st.x) * st.y;
                const float y0 = x0 * (e < 2 ? g0[2 * e] : g1[2 * e - 4]) + (e < 2 ? b0[2 * e] : b1[2 * e - 4]), y1 = x1 * (e < 2 ? g0[2 * e + 1] : g1[2 * e - 3]) + (e < 2 ? b0[2 * e + 1] : b1[2 * e - 3]);
                const unsigned pk = cvt_pk_bf16(y0, y1);
                vt[(2 * e) * (VTROW / 2)] = (unsigned short)(pk & 0xffffu); vt[(2 * e + 1) * (VTROW / 2)] = (unsigned short)(pk >> 16); } }
        __syncthreads();
        f32x4 acc[8];
#pragma unroll
        for (int nt = 0; nt < 8; ++nt) acc[nt] = (f32x4){0.f, 0.f, 0.f, 0.f};
        const bf16_t* wp = W + ((size_t)g * 128 + 16 * w + n16) * 128 + 8 * g4;
#pragma unroll
        for (int ks = 0; ks < 4; ++ks) { const bf16x8 af = *(const bf16x8*)(wp + 32 * ks);
#pragma unroll
            for (int nt = 0; nt < 8; ++nt) { const bf16x8 bf = *(const LAS bf16x8*)(lds + L_VT + (16 * nt + n16) * VTROW + (32 * ks + 8 * g4) * 2);
                acc[nt] = __builtin_amdgcn_mfma_f32_16x16x32_bf16(af, bf, acc[nt], 0, 0, 0); } }
#pragma unroll
        for (int rg = 0; rg < 4; ++rg) { const int p = 16 * w + 4 * g4 + rg; const float bb = bs[g * 128 + p]; const size_t tok = tb + p;
#pragma unroll
            for (int nt = 0; nt < 8; ++nt) { const int c = 16 * nt + n16; const float u = bf2f((unsigned)ZB[tok * 2048 + g * 128 + c]);
                OCAT[tok * 3072 + 1024 + g * 128 + c] = (bf16_t)f2bf(u * (acc[nt][rg] + bb)); } }
        __syncthreads();
    }
}
}


namespace psel {
using f32x16 = __attribute__((ext_vector_type(16))) float;
__device__ __forceinline__ int sortable(float f) { int s = __float_as_int(f); return s ^ ((s >> 31) & 0x7fffffff); }
__device__ __forceinline__ float unsort(int k) { return __int_as_float(k ^ ((k >> 31) & 0x7fffffff)); }
__device__ __forceinline__ int imax(int a, int b) { return a > b ? a : b; }
__device__ __forceinline__ int imin(int a, int b) { return a < b ? a : b; }
#define PS_INS(L, x) do { int v_ = (x); _Pragma("unroll") for (int i_ = 0; i_ < 16; ++i_) { const int h_ = imax(L[i_], v_); v_ = imin(L[i_], v_); L[i_] = h_; } } while (0)
#define PS_STAGE(c_, D) do { _Pragma("unroll") for (int i_ = 0; i_ < 16; ++i_) if ((i_ & (D)) == 0) { const int h_ = imax(c_[i_], c_[i_ + (D)]), l_ = imin(c_[i_], c_[i_ + (D)]); c_[i_] = h_; c_[i_ + (D)] = l_; } } while (0)
#define PS_MERGE(L) do { int c_[16]; _Pragma("unroll") for (int i_ = 0; i_ < 16; ++i_) c_[i_] = imax(L[i_], __shfl_xor(L[15 - i_], 32)); \
    PS_STAGE(c_, 8); PS_STAGE(c_, 4); PS_STAGE(c_, 2); PS_STAGE(c_, 1); \
    _Pragma("unroll") for (int i_ = 0; i_ < 16; ++i_) L[i_] = c_[i_]; } while (0)
#define PS_CAS(a, b) do { const int h__ = imax(a, b), l__ = imin(a, b); a = h__; b = l__; } while (0)
#define PS_BST(c, K, J) do { _Pragma("unroll") for (int i_ = 0; i_ < 16; ++i_) { if ((i_ ^ (J)) > i_) { if ((i_ & (K)) == 0) PS_CAS(c[i_], c[i_ ^ (J)]); else PS_CAS(c[i_ ^ (J)], c[i_]); } } } while (0)
__device__ __forceinline__ void sort16(int (&c)[16]) {
    PS_BST(c, 2, 1); PS_BST(c, 4, 2); PS_BST(c, 4, 1); PS_BST(c, 8, 4); PS_BST(c, 8, 2); PS_BST(c, 8, 1); PS_BST(c, 16, 8); PS_BST(c, 16, 4); PS_BST(c, 16, 2); PS_BST(c, 16, 1);
}
__device__ __forceinline__ void merge16(int (&L)[16], const int (&c)[16]) {
#pragma unroll
    for (int i = 0; i < 16; ++i) L[i] = imax(L[i], c[15 - i]);
    PS_STAGE(L, 8); PS_STAGE(L, 4); PS_STAGE(L, 2); PS_STAGE(L, 1);
}
__device__ __forceinline__ int sel16(const int (&v)[16], int i) { int r = v[0];
#pragma unroll
    for (int k = 1; k < 16; ++k) { r = (i == k) ? v[k] : r; asm volatile("" : "+v"(r)); }
    return r; }
__device__ __forceinline__ void side_list(int (&L)[16], const f32x4 (&sc)[16], int hi) {
    const int nb = 127 - 64 * hi;
#pragma unroll
    for (int q = 0; q < 4; ++q) {
        int c[16];
#pragma unroll
        for (int j = 0; j < 4; ++j) { c[j] = (sortable(sc[4 * q][j]) & ~127) | (nb - (16 * q + j)); c[4 + j] = (sortable(sc[4 * q + 1][j]) & ~127) | (nb - (16 * q + 4 + j));
            c[8 + j] = (sortable(sc[4 * q + 2][j]) & ~127) | (nb - (16 * q + 8 + j)); c[12 + j] = (sortable(sc[4 * q + 3][j]) & ~127) | (nb - (16 * q + 12 + j)); }
        sort16(c);
        if (q == 0) {
#pragma unroll
            for (int i = 0; i < 16; ++i) L[i] = c[i];
        } else merge16(L, c);
    }
    PS_MERGE(L);
}
template <bool TILE> __device__ __forceinline__ void phase(const int tid, unsigned char* ws, int G, int vcu, int pm, int hh) {
    const float* SC = (const float*)(ws + WS_SC); int* IDX = (int*)(ws + WS_IDX); float* GWT = (float*)(ws + WS_GW);
    const int lane = tid & 63, wave = __builtin_amdgcn_readfirstlane(tid >> 6), r32 = lane & 31, hi = lane >> 5;
    for (int task = TILE ? wave : vcu * NWAVES + wave; task < (TILE ? NWAVES : (T / 32) * 8); task += (TILE ? NWAVES : G * NWAVES)) {
        const int h = TILE ? hh : (task & 7), t0 = TILE ? pm * 256 + 32 * task : (task >> 3) * 32, t = t0 + r32;
        int v1[16], v2[16];
        f32x4 sa[16], sb[16];
        { const bf16_t* sp = (const bf16_t*)SC + (size_t)t * 2048 + h * 256 + 64 * hi; u32x4 wa_[8], wb_[8];
#pragma unroll
          for (int q = 0; q < 8; ++q) { wa_[q] = *(const u32x4*)(sp + 8 * q); wb_[q] = *(const u32x4*)(sp + 128 + 8 * q); }
#pragma unroll
          for (int q = 0; q < 8; ++q) { sa[2 * q] = (f32x4){bf2f(wa_[q][0] & 0xffffu), bf2f(wa_[q][0] >> 16), bf2f(wa_[q][1] & 0xffffu), bf2f(wa_[q][1] >> 16)}; sa[2 * q + 1] = (f32x4){bf2f(wa_[q][2] & 0xffffu), bf2f(wa_[q][2] >> 16), bf2f(wa_[q][3] & 0xffffu), bf2f(wa_[q][3] >> 16)};
              sb[2 * q] = (f32x4){bf2f(wb_[q][0] & 0xffffu), bf2f(wb_[q][0] >> 16), bf2f(wb_[q][1] & 0xffffu), bf2f(wb_[q][1] >> 16)}; sb[2 * q + 1] = (f32x4){bf2f(wb_[q][2] & 0xffffu), bf2f(wb_[q][2] >> 16), bf2f(wb_[q][3] & 0xffffu), bf2f(wb_[q][3] >> 16)}; } }
        side_list(v1, sa, hi);
        side_list(v2, sb, hi);
        float f1[16], f2[16];
#pragma unroll
        for (int i = 0; i < 16; ++i) { f1[i] = unsort(v1[i] & ~127); f2[i] = unsort(v2[i] & ~127); }
#define PS_CAND(I, J) ((sortable(f1[I] + f2[J]) & ~255) | (255 - ((I) * 16 + (J))))
        int C[16];
#pragma unroll
        for (int j = 0; j < 16; ++j) C[j] = PS_CAND(0, j);
        { int c[16];
#pragma unroll
          for (int j = 0; j < 8; ++j) c[j] = PS_CAND(1, j);
#pragma unroll
          for (int j = 0; j < 5; ++j) c[8 + j] = PS_CAND(2, j);
#pragma unroll
          for (int j = 0; j < 3; ++j) c[13 + j] = PS_CAND(3, j);
          sort16(c); merge16(C, c); }
        { int c[16];
          c[0] = PS_CAND(3, 3);
#pragma unroll
          for (int j = 0; j < 3; ++j) c[1 + j] = PS_CAND(4, j);
#pragma unroll
          for (int j = 0; j < 2; ++j) { c[4 + j] = PS_CAND(5, j); c[6 + j] = PS_CAND(6, j); c[8 + j] = PS_CAND(7, j); }
          c[10] = PS_CAND(8, 0); c[11] = PS_CAND(9, 0); c[12] = PS_CAND(10, 0); c[13] = PS_CAND(11, 0); c[14] = PS_CAND(12, 0); c[15] = PS_CAND(13, 0);
          sort16(c); merge16(C, c); }
        PS_INS(C, PS_CAND(14, 0)); PS_INS(C, PS_CAND(15, 0));
#undef PS_CAND
        const float b0 = unsort(C[0] & ~255); float e[16], sum = 0.f;
#pragma unroll
        for (int k = 0; k < 16; ++k) { e[k] = __expf(unsort(C[k] & ~255) - b0); sum += e[k]; }
        const float inv = 1.f / sum;
        int oi[8]; float og[8];
        const int hm = -hi;
#pragma unroll
        for (int k = 0; k < 8; ++k) { const int ck = (C[k] & ~hm) | (C[8 + k] & hm); const int code = 255 - (ck & 255), n1 = 127 - (sel16(v1, code >> 4) & 127), n2 = 127 - (sel16(v2, code & 15) & 127);
            oi[k] = n1 * 128 + n2; og[k] = __int_as_float((__float_as_int(e[k]) & ~hm) | (__float_as_int(e[8 + k]) & hm)) * inv; }
        int* ip = IDX + (size_t)t * 128 + h * 16 + 8 * hi; float* gp = GWT + (size_t)t * 128 + h * 16 + 8 * hi;
        *(u32x4*)ip = (u32x4){(unsigned)oi[0], (unsigned)oi[1], (unsigned)oi[2], (unsigned)oi[3]}; *(u32x4*)(ip + 4) = (u32x4){(unsigned)oi[4], (unsigned)oi[5], (unsigned)oi[6], (unsigned)oi[7]};
        *(f32x4*)gp = (f32x4){og[0], og[1], og[2], og[3]}; *(f32x4*)(gp + 4) = (f32x4){og[4], og[5], og[6], og[7]};
    }
}
#undef PS_INS
#undef PS_MERGE
#undef PS_STAGE
#undef PS_CAS
#undef PS_BST
}


template <bool USEPART> __device__ __forceinline__ void peer_gather8_phase(const int tid, unsigned char* ws, const unsigned char* pu, const unsigned char* pv, const float* final_g, float* out, int G, int vcu) {
    const int lane = tid & 63, wave = __builtin_amdgcn_readfirstlane(tid >> 6), hi = lane >> 5, sel = (lane >> 4) & 1;
    const float* RS2 = (const float*)(ws + WS_RS2); const int* IDX = (const int*)(ws + WS_IDX); const float* GWT = (const float*)(ws + WS_GW);
    float* X = (float*)(ws + WS_X); bf16_t* XB = (bf16_t*)(ws + WS_XB); float* RS = (float*)(ws + WS_RS);
    const bool local = (G * NWAVES * 4 == T);
    for (int it = 0; it < (local ? 4 : (T + G * NWAVES - 1) / (G * NWAVES)); ++it) { const int t = local ? 32 * vcu + 4 * wave + it : vcu * NWAVES + wave + it * G * NWAVES; if (t >= T) break;
        float xf[2][16];
#pragma unroll
        for (int c = 0; c < 2; ++c)
#pragma unroll
            for (int q = 0; q < 4; ++q) { const f32x4 v = *(const f32x4*)(X + (size_t)t * DM + c * 1024 + lane * 16 + 4 * q); xf[c][4 * q] = v[0]; xf[c][4 * q + 1] = v[1]; xf[c][4 * q + 2] = v[2]; xf[c][4 * q + 3] = v[3]; }
        const float rs2 = __hip_atomic_load(RS2 + t, __ATOMIC_RELAXED, __HIP_MEMORY_SCOPE_AGENT);
        const int e_lo = IDX[(size_t)t * 128 + lane], e_hi = IDX[(size_t)t * 128 + 64 + lane];
        const float g_lo = GWT[(size_t)t * 128 + lane], g_hi = GWT[(size_t)t * 128 + 64 + lane];
        float a_lo = 0.f, a_hi = 0.f;
#define P8_LOAD(R, tab, kk) do { _Pragma("unroll") for (int i = 0; i < 2; ++i) { const int e = __builtin_amdgcn_readlane((kk) < 64 ? e_lo : e_hi, ((kk) & 63) + i); const unsigned char* row = (tab) + (size_t)e * DM + lane * 16; \
            R[i][0] = *(const u32x4*)row; R[i][1] = *(const u32x4*)(row + 1024); } } while (0)
#define P8_DOT(R, kk) do { float p[2]; _Pragma("unroll") for (int i = 0; i < 2; ++i) { float s0 = 0.f, s1 = 0.f; \
            _Pragma("unroll") for (int c = 0; c < 2; ++c) _Pragma("unroll") for (int q = 0; q < 4; ++q) { const f32x2 lo = __builtin_amdgcn_cvt_pk_f32_fp8(R[i][c][q], false), hh = __builtin_amdgcn_cvt_pk_f32_fp8(R[i][c][q], true); \
                s0 += xf[c][4 * q] * lo.x + xf[c][4 * q + 1] * lo.y; s1 += xf[c][4 * q + 2] * hh.x + xf[c][4 * q + 3] * hh.y; } p[i] = s0 + s1; } \
            float rr = (hi ? p[1] : p[0]) + __shfl_xor(hi ? p[0] : p[1], 32); rr += __shfl_xor(rr, 16); rr += __shfl_xor(rr, 8); rr += __shfl_xor(rr, 4); rr += __shfl_xor(rr, 2); rr += __shfl_xor(rr, 1); \
            const int k2 = (kk) & 63; const float v_ = __shfl(rr, ((lane - k2) & 1) * 32); if (lane >= k2 && lane < k2 + 2) { if ((kk) < 64) a_lo = v_; else a_hi = v_; } } while (0)
#define P8_AXPY(R, kk) do { _Pragma("unroll") for (int i = 0; i < 2; ++i) { const float wk = __uint_as_float(__builtin_amdgcn_readlane(__float_as_uint((kk) < 64 ? w_lo : w_hi), ((kk) & 63) + i)); \
            _Pragma("unroll") for (int c = 0; c < 2; ++c) _Pragma("unroll") for (int q = 0; q < 4; ++q) { const f32x2 lo = __builtin_amdgcn_cvt_pk_f32_fp8(R[i][c][q], false), hh = __builtin_amdgcn_cvt_pk_f32_fp8(R[i][c][q], true); \
                y[c][4 * q] += wk * lo.x; y[c][4 * q + 1] += wk * lo.y; y[c][4 * q + 2] += wk * hh.x; y[c][4 * q + 3] += wk * hh.y; } } } while (0)
#define P8_FENCE() asm volatile("" ::: "memory")
        u32x4 rA[2][2], rB[2][2];
        if constexpr (USEPART) {
            const float* pp = (const float*)(ws + WS_PART) + (size_t)t * 128 + lane;
#pragma unroll
            for (int x_ = 0; x_ < 8; ++x_) { a_lo += pp[(size_t)x_ * T * 128]; a_hi += pp[(size_t)x_ * T * 128 + 64]; }
        } else {
        P8_LOAD(rA, pu, 0); P8_FENCE();
        for (int k0 = 0; k0 < 128; k0 += 4) {
            P8_LOAD(rB, pu, k0 + 2); P8_FENCE();
            P8_DOT(rA, k0); P8_FENCE();
            if (k0 + 4 < 128) P8_LOAD(rA, pu, k0 + 4);
            P8_FENCE();
            P8_DOT(rB, k0 + 2); P8_FENCE();
        }
        }
        P8_LOAD(rA, pv, 0); P8_FENCE();
        const float w_lo = gelu_tanh(rs2 * (1.f / PU_SCALE) * a_lo) * g_lo, w_hi = gelu_tanh(rs2 * (1.f / PU_SCALE) * a_hi) * g_hi;
        float y[2][16];
#pragma unroll
        for (int c = 0; c < 2; ++c)
#pragma unroll
            for (int j = 0; j < 16; ++j) y[c][j] = 0.f;
        for (int k0 = 0; k0 < 128; k0 += 4) {
            P8_LOAD(rB, pv, k0 + 2); P8_FENCE();
            P8_AXPY(rA, k0); P8_FENCE();
            if (k0 + 4 < 128) P8_LOAD(rA, pv, k0 + 4);
            P8_FENCE();
            P8_AXPY(rB, k0 + 2); P8_FENCE();
        }
#undef P8_LOAD
#undef P8_DOT
#undef P8_AXPY
#undef P8_FENCE
        float ss = 0.f;
#pragma unroll
        for (int c = 0; c < 2; ++c)
#pragma unroll
            for (int j = 0; j < 16; ++j) { y[c][j] = xf[c][j] + y[c][j] * (1.f / PV_SCALE); ss += y[c][j] * y[c][j]; }
        const float rn = rsqrtf(wave_sum(ss) * (1.f / DM) + EPS);
        float am = 0.f;
        if (!out) {
#pragma unroll
            for (int c = 0; c < 2; ++c)
#pragma unroll
                for (int j = 0; j < 16; ++j) am = fmaxf(am, fabsf(y[c][j]));
#pragma unroll
            for (int o_ = 1; o_ < 64; o_ <<= 1) am = fmaxf(am, __shfl_xor(am, o_)); }
        const float qinv = am > 0.f ? 127.f / am : 0.f;
        int lo16 = lane * 16; asm volatile("" : "+v"(lo16));
#pragma unroll
        for (int c = 0; c < 2; ++c) { const size_t off = (size_t)t * DM + c * 1024 + lo16;
            if (out) {
#pragma unroll
                for (int q = 0; q < 4; ++q) { const f32x4 gq = *(const f32x4*)(final_g + c * 1024 + lo16 + 4 * q);
                    *(f32x4*)(out + off + 4 * q) = (f32x4){y[c][4 * q] * rn * gq[0], y[c][4 * q + 1] * rn * gq[1], y[c][4 * q + 2] * rn * gq[2], y[c][4 * q + 3] * rn * gq[3]}; }
            } else {
#pragma unroll
                for (int q = 0; q < 4; ++q) *(f32x4*)(X + off + 4 * q) = (f32x4){y[c][4 * q], y[c][4 * q + 1], y[c][4 * q + 2], y[c][4 * q + 3]};
                store8_bf16(XB + off, (f32x4){y[c][0], y[c][1], y[c][2], y[c][3]}, (f32x4){y[c][4], y[c][5], y[c][6], y[c][7]});
                store8_bf16(XB + off + 8, (f32x4){y[c][8], y[c][9], y[c][10], y[c][11]}, (f32x4){y[c][12], y[c][13], y[c][14], y[c][15]});
                *(u32x4*)(ws + WS_XQ + off) = (u32x4){pack4_q8(y[c][0] * qinv, y[c][1] * qinv, y[c][2] * qinv, y[c][3] * qinv), pack4_q8(y[c][4] * qinv, y[c][5] * qinv, y[c][6] * qinv, y[c][7] * qinv),
                                                     pack4_q8(y[c][8] * qinv, y[c][9] * qinv, y[c][10] * qinv, y[c][11] * qinv), pack4_q8(y[c][12] * qinv, y[c][13] * qinv, y[c][14] * qinv, y[c][15] * qinv)};
            } }
        if (!out && lane == 0) { RS[t] = rn; ((float*)(ws + WS_SA))[t] = am * (1.f / 127.f); }
    }
}


namespace krp {
using f32x16 = __attribute__((ext_vector_type(16))) float;
__device__ __forceinline__ void phase(const int tid, unsigned char* ws, const bf16_t* WKR, LAS unsigned char* lds, int G, int vcu) {
    const bf16_t* XB = (const bf16_t*)(ws + WS_XB); const float* RS = (const float*)(ws + WS_RS); const f32x2* rope = (const f32x2*)(ws + WS_ROPE); bf16_t* KF = (bf16_t*)(ws + WS_KF);
    const int lane = tid & 63, w = __builtin_amdgcn_readfirstlane(tid >> 6), r32 = lane & 31, hi = lane >> 5;
    LAS float* P = (LAS float*)lds;
    for (int task = vcu; task < T / 32; task += G) {
        const int t0 = task * 32;
        f32x16 acc0 = {}, acc1 = {};
        const bf16_t* xp = XB + (size_t)(t0 + r32) * DM + 256 * w + 8 * hi; const bf16_t* wp = WKR + (size_t)r32 * DM + 256 * w + 8 * hi;
#pragma unroll
        for (int ks = 0; ks < 16; ++ks) { const bf16x8 b = *(const bf16x8*)(xp + 16 * ks), a0 = *(const bf16x8*)(wp + 16 * ks), a1 = *(const bf16x8*)(wp + (size_t)32 * DM + 16 * ks);
            acc0 = __builtin_amdgcn_mfma_f32_32x32x16_bf16(a0, b, acc0, 0, 0, 0); acc1 = __builtin_amdgcn_mfma_f32_32x32x16_bf16(a1, b, acc1, 0, 0, 0); }
        __syncthreads();
#pragma unroll
        for (int r = 0; r < 16; ++r) { P[((w * 2 + 0) * 16 + r) * 64 + lane] = acc0[r]; P[((w * 2 + 1) * 16 + r) * 64 + lane] = acc1[r]; }
        __syncthreads();
        const int tok = tid & 31, tile = (tid >> 5) & 1, jq = tid >> 6, src = tok + 32 * (jq & 1);
        float v[4] = {0.f, 0.f, 0.f, 0.f};
#pragma unroll
        for (int ww = 0; ww < 8; ++ww)
#pragma unroll
            for (int c = 0; c < 4; ++c) v[c] += P[((ww * 2 + tile) * 16 + 4 * (jq >> 1) + c) * 64 + src];
        const int t = t0 + tok, jg = 32 * tile + 4 * jq; const float rs = RS[t];
        const f32x2 c0 = rope[(size_t)(t & (SEQ - 1)) * 32 + (jg >> 1)], c1 = rope[(size_t)(t & (SEQ - 1)) * 32 + (jg >> 1) + 1];
        const float x0 = v[0] * rs, x1 = v[1] * rs, x2 = v[2] * rs, x3 = v[3] * rs;
        u32x2 o; o.x = cvt_pk_bf16(x0 * c0.x - x1 * c0.y, x1 * c0.x + x0 * c0.y); o.y = cvt_pk_bf16(x2 * c1.x - x3 * c1.y, x3 * c1.x + x2 * c1.y);
#pragma unroll
        for (int h = 0; h < 8; ++h) *(u32x2*)(KF + (size_t)t * 1536 + h * 192 + 128 + jg) = o;
    }
    __syncthreads();
}
}


template <int CTRL> __device__ __forceinline__ float dpp_add(float v) { return v + __int_as_float(__builtin_amdgcn_update_dpp(0, __float_as_int(v), CTRL, 0xf, 0xf, true)); }
__device__ __forceinline__ float row16_sum(float v) { v = dpp_add<0xB1>(v); v = dpp_add<0x4E>(v); v = dpp_add<0x141>(v); v = dpp_add<0x140>(v); return v; }
__device__ __forceinline__ void peer_u_sliced_phase(const int tid, unsigned char* ws, const unsigned char* pu, int G, int vcu) {
    const int lane = tid & 63, wave = __builtin_amdgcn_readfirstlane(tid >> 6), q = lane >> 4, j = lane & 15;
    const int wps = G / 8, xs = vcu / wps, wi = (vcu % wps) * NWAVES + wave, nws = wps * NWAVES;
    if (xs >= 8) return;
    const float* X = (const float*)(ws + WS_X); const int* IDX = (const int*)(ws + WS_IDX); float* PART = (float*)(ws + WS_PART) + (size_t)xs * T * 128;
    const unsigned ub = (unsigned)(256 * xs + 16 * j);
    for (int t = wi; t < T; t += nws) {
        f32x2 xv[8];
        { const bf16_t* xp = (const bf16_t*)(ws + WS_XB) + (size_t)t * DM + 256 * xs + 16 * j; const u32x4 w0 = *(const u32x4*)xp, w1 = *(const u32x4*)(xp + 8);
#pragma unroll
          for (int c = 0; c < 4; ++c) { xv[c] = (f32x2){bf2f(w0[c] & 0xffffu), bf2f(w0[c] >> 16)}; xv[4 + c] = (f32x2){bf2f(w1[c] & 0xffffu), bf2f(w1[c] >> 16)}; } }
        const int e_lo = IDX[(size_t)t * 128 + lane], e_hi = IDX[(size_t)t * 128 + 64 + lane];
        float r0 = 0.f, r1 = 0.f;
#define US_LOAD(R, I0) do { _Pragma("unroll") for (int i = 0; i < 8; ++i) { const int e = __shfl((I0) < 16 ? e_lo : e_hi, (4 * ((I0) + i) + q) & 63); R[i] = *(const u32x4*)(pu + (((unsigned)e << 11) + ub)); } } while (0)
#define US_DOT(R, I0) do { _Pragma("unroll") for (int i = 0; i < 8; ++i) { f32x2 s0 = {0.f, 0.f}, s1 = {0.f, 0.f}; \
            _Pragma("unroll") for (int c = 0; c < 4; ++c) { const f32x2 lo = __builtin_amdgcn_cvt_pk_f32_fp8(R[i][c], false), hh = __builtin_amdgcn_cvt_pk_f32_fp8(R[i][c], true); \
                s0 = __builtin_elementwise_fma(xv[2 * c], lo, s0); s1 = __builtin_elementwise_fma(xv[2 * c + 1], hh, s1); } \
            s0 += s1; const float v_ = row16_sum(s0.x + s0.y); if ((I0) < 16) r0 = (j == (((I0) + i) & 15)) ? v_ : r0; else r1 = (j == (((I0) + i) & 15)) ? v_ : r1; } } while (0)
        u32x4 ra[8], rb[8];
        US_LOAD(ra, 0); asm volatile("" ::: "memory");
        US_LOAD(rb, 8); asm volatile("" ::: "memory");
        US_DOT(ra, 0); asm volatile("" ::: "memory");
        US_LOAD(ra, 16); asm volatile("" ::: "memory");
        US_DOT(rb, 8); asm volatile("" ::: "memory");
        US_LOAD(rb, 24); asm volatile("" ::: "memory");
        US_DOT(ra, 16); asm volatile("" ::: "memory");
        US_DOT(rb, 24);
#undef US_LOAD
#undef US_DOT
        float* pp = PART + (size_t)t * 128 + 4 * j + q;
        pp[0] = r0; pp[64] = r1;
    }
}

__device__ __forceinline__ void peer_v_sliced_phase(const int tid, unsigned char* ws, const unsigned char* pv, int G, int vcu) {
    const int lane = tid & 63, wave = __builtin_amdgcn_readfirstlane(tid >> 6), q = lane >> 4, j = lane & 15;
    const int wps = G / 8, xs = vcu / wps, wi = (vcu % wps) * NWAVES + wave, nws = wps * NWAVES;
    const int* IDX = (const int*)(ws + WS_IDX); const float* GWT = (const float*)(ws + WS_GW); const float* PART = (const float*)(ws + WS_PART); const float* RS2 = (const float*)(ws + WS_RS2);
    float* XSS = (float*)(ws + WS_XSS);
    if (xs >= 8) return;
    const unsigned vb = (unsigned)(256 * xs + 16 * j);
    for (int t = wi; t < T; t += nws) {
        const int e_lo = IDX[(size_t)t * 128 + lane], e_hi = IDX[(size_t)t * 128 + 64 + lane];
        float a_lo = 0.f, a_hi = 0.f;
        { const float* pp = PART + (size_t)t * 128 + lane;
#pragma unroll
          for (int x_ = 0; x_ < 8; ++x_) { a_lo += pp[(size_t)x_ * T * 128]; a_hi += pp[(size_t)x_ * T * 128 + 64]; } }
        const float rs2 = __hip_atomic_load(RS2 + t, __ATOMIC_RELAXED, __HIP_MEMORY_SCOPE_AGENT);
        const float w_lo = gelu_tanh(rs2 * (1.f / PU_SCALE) * a_lo) * GWT[(size_t)t * 128 + lane], w_hi = gelu_tanh(rs2 * (1.f / PU_SCALE) * a_hi) * GWT[(size_t)t * 128 + 64 + lane];
        f32x2 y2[8];
#pragma unroll
        for (int i = 0; i < 8; ++i) y2[i] = (f32x2){0.f, 0.f};
        const int pk_lo = (int)((cvt_pk_bf16(0.f, w_lo) & 0xffff0000u) | (unsigned)e_lo), pk_hi = (int)((cvt_pk_bf16(0.f, w_hi) & 0xffff0000u) | (unsigned)e_hi);
#define VS_LOAD(R, P, I0) do { _Pragma("unroll") for (int i = 0; i < 8; ++i) { P[i] = __shfl((I0) < 16 ? pk_lo : pk_hi, (4 * ((I0) + i) + q) & 63); R[i] = *(const u32x4*)(pv + ((((unsigned)P[i] & 0xffffu) << 11) + vb)); } } while (0)
#define VS_AXPY(R, P, I0) do { _Pragma("unroll") for (int i = 0; i < 8; ++i) { const float wk = __uint_as_float((unsigned)P[i] & 0xffff0000u); \
            const f32x2 wk2 = {wk, wk}; \
            _Pragma("unroll") for (int c = 0; c < 4; ++c) { const f32x2 lo = __builtin_amdgcn_cvt_pk_f32_fp8(R[i][c], false), hh = __builtin_amdgcn_cvt_pk_f32_fp8(R[i][c], true); \
                y2[2 * c] = __builtin_elementwise_fma(wk2, lo, y2[2 * c]); y2[2 * c + 1] = __builtin_elementwise_fma(wk2, hh, y2[2 * c + 1]); } } } while (0)
        u32x4 ra[8], rb[8]; int pa[8], pb[8];
        VS_LOAD(ra, pa, 0); asm volatile("" ::: "memory");
#pragma unroll 1
        for (int g0 = 0; g0 < 32; g0 += 16) {
            VS_LOAD(rb, pb, g0 + 8); asm volatile("" ::: "memory");
            VS_AXPY(ra, pa, g0); asm volatile("" ::: "memory");
            if (g0 + 16 < 32) VS_LOAD(ra, pa, g0 + 16);
            asm volatile("" ::: "memory");
            VS_AXPY(rb, pb, g0 + 8); asm volatile("" ::: "memory");
        }
#undef VS_LOAD
#undef VS_AXPY
        float y[16];
#pragma unroll
        for (int i = 0; i < 8; ++i) { y[2 * i] = y2[i].x; y[2 * i + 1] = y2[i].y; }
#pragma unroll
        for (int i = 0; i < 16; ++i) { y[i] += __shfl_xor(y[i], 16); y[i] += __shfl_xor(y[i], 32); }
        f32x4 mine;
#pragma unroll
        for (int i = 0; i < 4; ++i) { float v = y[i]; v = (q == 1) ? y[4 + i] : v; asm volatile("" : "+v"(v)); v = (q == 2) ? y[8 + i] : v; asm volatile("" : "+v"(v)); v = (q == 3) ? y[12 + i] : v; asm volatile("" : "+v"(v)); mine[i] = v; }
        const u32x2 xw = *(const u32x2*)((const bf16_t*)(ws + WS_XB) + (size_t)t * DM + 256 * xs + 16 * j + 4 * q); const f32x4 x1 = {bf2f(xw.x & 0xffffu), bf2f(xw.x >> 16), bf2f(xw.y & 0xffffu), bf2f(xw.y >> 16)}; const f32x4 of = x1 + mine * (1.f / PV_SCALE);
        const u32x2 ow = {cvt_pk_bf16(of[0], of[1]), cvt_pk_bf16(of[2], of[3])};
        *(u32x2*)((bf16_t*)(ws + WS_XB) + (size_t)t * DM + 256 * xs + 16 * j + 4 * q) = ow;
        const f32x4 o = {bf2f(ow.x & 0xffffu), bf2f(ow.x >> 16), bf2f(ow.y & 0xffffu), bf2f(ow.y >> 16)};
        float ss = (o[0] * o[0] + o[1] * o[1]) + (o[2] * o[2] + o[3] * o[3]), am = fmaxf(fmaxf(fabsf(o[0]), fabsf(o[1])), fmaxf(fabsf(o[2]), fabsf(o[3])));
        ss = wave_sum(ss);
#pragma unroll
        for (int o_ = 1; o_ < 64; o_ <<= 1) am = fmaxf(am, __shfl_xor(am, o_));
        if (lane == 0) { XSS[(size_t)t * 32 + xs] = ss; XSS[(size_t)t * 32 + 8 + xs] = am; }
    }
}
__device__ __forceinline__ void peer_finish_phase(const int tid, unsigned char* ws, const float* final_g, float* out, int G, int vcu) {
    const int lane = tid & 63, wave = __builtin_amdgcn_readfirstlane(tid >> 6);
    const bf16_t* XB = (const bf16_t*)(ws + WS_XB); float* RS = (float*)(ws + WS_RS); const float* XSS = (const float*)(ws + WS_XSS);
    for (int t = vcu * NWAVES + wave; t < T; t += G * NWAVES) {
        const f32x4 s0 = *(const f32x4*)(XSS + (size_t)t * 32), s1 = *(const f32x4*)(XSS + (size_t)t * 32 + 4), m0 = *(const f32x4*)(XSS + (size_t)t * 32 + 8), m1 = *(const f32x4*)(XSS + (size_t)t * 32 + 12);
        const float rn = rsqrtf(((s0[0] + s0[1]) + (s0[2] + s0[3]) + (s1[0] + s1[1]) + (s1[2] + s1[3])) * (1.f / DM) + EPS);
        const float am = fmaxf(fmaxf(fmaxf(m0[0], m0[1]), fmaxf(m0[2], m0[3])), fmaxf(fmaxf(m1[0], m1[1]), fmaxf(m1[2], m1[3])));
        const float qinv = am > 0.f ? 127.f / am : 0.f;
#pragma unroll
        for (int c = 0; c < 2; ++c) { const size_t off = (size_t)t * DM + c * 1024 + lane * 16; f32x4 y[4];
#pragma unroll
            for (int q = 0; q < 2; ++q) { const u32x4 w = *(const u32x4*)(XB + off + 8 * q); y[2 * q] = (f32x4){bf2f(w.x & 0xffffu), bf2f(w.x >> 16), bf2f(w.y & 0xffffu), bf2f(w.y >> 16)}; y[2 * q + 1] = (f32x4){bf2f(w.z & 0xffffu), bf2f(w.z >> 16), bf2f(w.w & 0xffffu), bf2f(w.w >> 16)}; }
            if (out) {
#pragma unroll
                for (int q = 0; q < 4; ++q) { const f32x4 gq = *(const f32x4*)(final_g + c * 1024 + lane * 16 + 4 * q); *(f32x4*)(out + off + 4 * q) = y[q] * rn * gq; }
            } else {
                *(u32x4*)(ws + WS_XQ + off) = (u32x4){pack4_q8(y[0][0] * qinv, y[0][1] * qinv, y[0][2] * qinv, y[0][3] * qinv), pack4_q8(y[1][0] * qinv, y[1][1] * qinv, y[1][2] * qinv, y[1][3] * qinv),
                                                     pack4_q8(y[2][0] * qinv, y[2][1] * qinv, y[2][2] * qinv, y[2][3] * qinv), pack4_q8(y[3][0] * qinv, y[3][1] * qinv, y[3][2] * qinv, y[3][3] * qinv)};
            } }
        if (!out && lane == 0) { RS[t] = rn; ((float*)(ws + WS_SA))[t] = am * (1.f / 127.f); }
    }
}

#define XB_TMO      128
#define XB_XCNT(j)  (256  + 64 * (j))
#define XB_XSUB(j)  (1280 + 64 * (j))
#define XB_XGEN(j)  (2304 + 64 * (j))
#define XB_TOP      3328
#define XB_TOPGEN   3392
#define XCD_BAR_WORDS 3456
#define XB_SPIN_CAP (1u << 22)
__device__ __forceinline__ unsigned xb_ld(unsigned* p)              { return __hip_atomic_load(p, __ATOMIC_RELAXED, __HIP_MEMORY_SCOPE_AGENT); }
__device__ __forceinline__ unsigned xb_add(unsigned* p, unsigned v) { return __hip_atomic_fetch_add(p, v, __ATOMIC_RELAXED, __HIP_MEMORY_SCOPE_AGENT); }
__device__ __forceinline__ unsigned xb_xcc_id() { return (unsigned)__builtin_amdgcn_s_getreg((3 << 11) | 20) & 0xFu; }
#define XB_SPIN(cond, bar) do { unsigned _sp = 0; while (cond) { __builtin_amdgcn_s_sleep(1); \
    if ((++_sp & 255u) == 0u) { if (xb_ld(&(bar)[XB_TMO])) break; if (_sp > XB_SPIN_CAP) { atomicAdd(&(bar)[XB_TMO], 1u); break; } } } } while (0)
__device__ __forceinline__ void xcd_barrier_complete(unsigned* bar, unsigned x, unsigned& nloc, unsigned& nx) {
    const unsigned G = gridDim.x;
    unsigned sum, cnt, mine, sp = 0u;
    for (;;) {
        sum = 0u; cnt = 0u; mine = 0u;
#pragma unroll
        for (unsigned j = 0; j < 16; ++j) { const unsigned c = xb_ld(&bar[XB_XCNT(j)]); sum += c; cnt += (c > 0u) ? 1u : 0u; mine = (j == x) ? c : mine; }
        if (sum == G) break;
        __builtin_amdgcn_s_sleep(1);
        if ((++sp & 255u) == 0u) { if (xb_ld(&bar[XB_TMO])) break; if (sp > XB_SPIN_CAP) { atomicAdd(&bar[XB_TMO], 1u); break; } }
    }
    nloc = mine > 0u ? mine : 1u; nx = cnt > 0u ? cnt : 1u;
}
__device__ __forceinline__ void xcd_barrier(unsigned* bar, volatile LAS unsigned* st, const int tid) {
    asm volatile("s_waitcnt vmcnt(0)" ::: "memory");
    __syncthreads();
    if (tid == 0) {
        __builtin_amdgcn_s_waitcnt(0);
        const unsigned x = xb_xcc_id();
        unsigned nloc = st[0], nx = st[1];
        if (nloc == 0u) { xcd_barrier_complete(bar, x, nloc, nx); st[0] = nloc; st[1] = nx; }
        const unsigned old = xb_add(&bar[XB_XSUB(x)], 1u);
        const unsigned gen = old / nloc;
        if (old + 1u == (gen + 1u) * nloc) {
            __builtin_amdgcn_fence(__ATOMIC_RELEASE, "agent");
            asm volatile("s_waitcnt vmcnt(0)" ::: "memory");
            const unsigned og = xb_add(&bar[XB_TOP], 1u);
            const unsigned tg = og / nx;
            if (og + 1u == (tg + 1u) * nx) {
#pragma unroll
                for (unsigned j = 0; j < 16; ++j) __hip_atomic_fetch_add(&bar[XB_XGEN(j)], 1u, __ATOMIC_RELAXED, __HIP_MEMORY_SCOPE_AGENT);
            }
        }
        XB_SPIN(xb_ld(&bar[XB_XGEN(x)]) == gen, bar);
        __builtin_amdgcn_fence(__ATOMIC_ACQUIRE, "agent");
        asm volatile("s_waitcnt vmcnt(0)" ::: "memory");
    }
    __syncthreads();
}

static_assert(offsetof(Args, ph_lo) == 216 && offsetof(Args, pad) == 228, "Args layout");
__device__ __forceinline__ bool ph_in(int k) { const int* p = (const int*)__builtin_amdgcn_kernarg_segment_ptr(); asm volatile("" : "+s"(p)); return p[54] <= k && k < p[55]; }
__device__ __forceinline__ int arg_int(int i) { const int* p = (const int*)__builtin_amdgcn_kernarg_segment_ptr(); asm volatile("" : "+s"(p)); return p[i]; }
#define GRID_SYNC() do { const float* const* inp_ = (const float* const*)__builtin_amdgcn_kernarg_segment_ptr(); asm volatile("" : "+s"(inp_)); \
        xcd_barrier((unsigned*)inp_[26] + CW_BAR, bst, otid(wave_s)); } while (0)
#define LANE_IDS() const int tid = otid(wave_s), lane = tid & 63, wave = __builtin_amdgcn_readfirstlane(tid >> 6), gw = vcu * NWAVES + wave; (void)lane; (void)gw
#define PHASE_PTRS() const float* const* inp = args.in; unsigned char* ws = args.ws; unsigned char* wl = ws + WS_W + (size_t)l * WL_STRIDE; (void)wl; (void)inp
#define IN(k) (args.ph_lo <= (k) && (k) < args.ph_hi)
#define SEAM(k) do { if (IN(k) && IN((k) + 1)) GRID_SYNC(); } while (0)

template <int L> __device__ __forceinline__ void layer_body(const Args& args, LAS unsigned char* lds, const int wave_s, const int G, const int bx, const int vcu, const int NGW, volatile LAS unsigned* bst) {
    constexpr int l = L;
        if (IN(PH_A)) {
            PHASE_PTRS(); LANE_IDS();
            { pg8::Gemm g{(const bf16_t*)(ws + WS_XQ), (const bf16_t*)(ws + WS_WGQ + (size_t)l * 12288 * DM), T, 12288, DM / 2}; pg8::StaticOrder S; S.init(T, 12288, G, bx);
              EpiA8 E{ws, inp[16] + (size_t)l * 6144, (const float*)(ws + WS_SB) + l * 12288};
              pg8::gemm_phase<EpiA8, pg8::StaticOrder, true, true, true>(lds, g, S, E, tid); }
        }
        SEAM(PH_A);
        if (IN(PH_B)) {
            { PHASE_PTRS(); LANE_IDS(); static_assert(WO_WUKV == WO_WUQ + (size_t)1536 * 512 * 2 && WS_CKV > WS_CQ, "up-projection weights adjacent");
              pg8::Gemm g{(const bf16_t*)(ws + WS_CQ), (const bf16_t*)(wl + WO_WUQ), T, 3584, 512, (long)(WS_CKV - WS_CQ), 6}; pg8::StaticOrder S; S.init(T, 3584, G, bx);
              EpiUp E{EpiQup{(const float*)(ws + WS_CQSS), (const f32x2*)(ws + WS_ROPE), (bf16_t*)(ws + WS_QF)}, EpiKVup{(const float*)(ws + WS_CKVSS), (bf16_t*)(ws + WS_KF), (bf16_t*)(ws + WS_VF)}};
              pg8::gemm_phase<EpiUp, pg8::StaticOrder, true, true>(lds, g, S, E, tid); }
            { PHASE_PTRS(); LANE_IDS(); krp::phase(tid, ws, (const bf16_t*)(wl + WO_WA) + (size_t)12288 * DM, lds, G, vcu); }
            { PHASE_PTRS(); LANE_IDS(); na3::phase(tid, ws, inp[3] + (size_t)l * 8 * 15 * 31, lds, G, vcu); }
            { PHASE_PTRS(); LANE_IDS(); sgu::phase(tid, ws, (const bf16_t*)(wl + WO_SGUW), inp[4] + l * 1024, inp[5] + l * 1024, inp[7] + l * 1024, lds, G, vcu); }
        }
        SEAM(PH_B);
        if (IN(PH_C)) {
            { PHASE_PTRS(); LANE_IDS(); mla_attn_phase(tid, ws, lds, G, vcu); }
        }
        SEAM(PH_C);
        if (IN(PH_D)) {
            PHASE_PTRS(); LANE_IDS();
            pg8::Gemm g{(const bf16_t*)(ws + WS_OCAT), (const bf16_t*)(wl + WO_WBR), T, DM, 3072}; pg8::StaticOrder S; S.init(T, DM, G, bx);
            EpiMerge E{(const bf16_t*)(ws + WS_GATES), (bf16_t*)(ws + WS_MERGED)};
            pg8::gemm_phase<EpiMerge, pg8::StaticOrder, true, true>(lds, g, S, E, tid);
        }
        SEAM(PH_D);
        if (IN(PH_E)) {
            PHASE_PTRS(); LANE_IDS();
            pg8::Gemm g{(const bf16_t*)(ws + WS_MERGED), (const bf16_t*)(wl + WO_WOUT), T, DM, DM}; pg8::StaticOrder S; S.init(T, DM, G, bx);
            EpiOutT<true> E{inp[0], (bf16_t*)(ws + WS_XB), (float*)(ws + WS_XSS)};
            pg8::gemm_phase<EpiOutT<true>, pg8::StaticOrder, true, true>(lds, g, S, E, tid);
            if (IN(PH_F)) { if (tid == 0) { unsigned* sc_ = (unsigned*)ws + CW_STRIP + l * 1024; __builtin_amdgcn_fence(__ATOMIC_RELEASE, "agent"); asm volatile("s_waitcnt vmcnt(0)" ::: "memory");
                    pg8::Unit u; for (int ui = 0; S.next(ui, u); ++ui) (void)xb_add(&sc_[u.pm * 16], 1u); } }
        }
        if (IN(PH_F)) {
            PHASE_PTRS(); LANE_IDS();
            pg8::Gemm g{(const bf16_t*)(ws + WS_XB), (const bf16_t*)(wl + WO_WQ), T, DM, DM}; pg8::StaticOrder S; S.init(T, DM, G, bx);
            EpiQuery E{(const float*)(ws + WS_XSS), (float*)(ws + WS_SC), (float*)(ws + WS_RS2)};
            if (IN(PH_E)) {
                if (tid == 0) { unsigned* sc_ = (unsigned*)ws + CW_STRIP + l * 1024; unsigned* bar = (unsigned*)ws + CW_BAR; pg8::Unit u;
                    for (int ui = 0; S.next(ui, u); ++ui) XB_SPIN(xb_ld(&sc_[u.pm * 16]) < (unsigned)(DM / 256), bar); }
                __syncthreads(); __builtin_amdgcn_fence(__ATOMIC_ACQUIRE, "agent"); }
            pg8::gemm_phase<EpiQuery, pg8::StaticOrder, true, true>(lds, g, S, E, tid);
            if (IN(PH_G1)) { __builtin_amdgcn_fence(__ATOMIC_ACQUIRE, "agent"); pg8::Unit u; for (int ui = 0; S.next(ui, u); ++ui) psel::phase<true>(tid, ws, G, vcu, u.pm, u.pn); }
        }
        if (IN(PH_F) && IN(PH_G2)) GRID_SYNC();
        if (IN(PH_G2)) { PHASE_PTRS(); LANE_IDS(); peer_u_sliced_phase(tid, ws, (const unsigned char*)(wl + WO_PU), G, vcu); }
        if (IN(PH_G2)) GRID_SYNC();
        if (IN(PH_G2)) { PHASE_PTRS(); LANE_IDS(); peer_v_sliced_phase(tid, ws, (const unsigned char*)(wl + WO_PV), G, vcu); }
        if (IN(PH_G2)) GRID_SYNC();
        if (IN(PH_G2)) { PHASE_PTRS(); LANE_IDS(); peer_finish_phase(tid, ws, inp[24], l == DEPTH - 1 ? args.out : (float*)nullptr, G, vcu); }
}

__global__ void __launch_bounds__(NWAVES * 64, 2) mk_fwd(Args args) {
    extern __shared__ __attribute__((aligned(16))) unsigned char lds_raw[];
    LAS unsigned char* lds = (LAS unsigned char*)lds_raw;
    const int wave_s = __builtin_amdgcn_readfirstlane((int)threadIdx.x >> 6);
    const int G = gridDim.x, bx = blockIdx.x, vcu = (G % 8 == 0) ? (bx % 8) * (G / 8) + bx / 8 : bx, NGW = G * NWAVES;
    volatile LAS unsigned* bst = (volatile LAS unsigned*)(lds + LDS_BYTES - 16);
    { const int tid = otid(wave_s); if (tid == 0) { bst[0] = 0u; bst[1] = 0u; unsigned* bar = (unsigned*)args.ws + CW_BAR; (void)xb_add(&bar[XB_XCNT(xb_xcc_id())], 1u); } __syncthreads(); }
    if (IN(PH_P0)) { LANE_IDS(); p0_prologue(args, lds, gw, NGW, wave, lane); p0_key_fold(args, gw, NGW, lane); __syncthreads(); p0_quant_strips(args, lds, tid, G, bx); }
    if (args.pad < 0) cg::this_grid().sync();
    if (IN(PH_P0) && IN(PH_A)) { GRID_SYNC(); }
    if (args.layer <= 0 && 0 < args.pad) layer_body<0>(args, lds, wave_s, G, bx, vcu, NGW, bst);
    if (args.layer <= 0 && 1 < args.pad && IN(PH_G2) && IN(PH_A)) GRID_SYNC();
    if (args.layer <= 1 && 1 < args.pad) layer_body<1>(args, lds, wave_s, G, bx, vcu, NGW, bst);
}

extern "C" void kernel_launch(void* const* d_in, const int* in_sizes, int n_in, void* d_out, int out_size, void* d_ws, size_t ws_size, hipStream_t stream) {
    static int grid = 0;
    if (grid == 0) {
        if (n_in != 25 || ws_size < WS_END || out_size != T * DM) { fprintf(stderr, "kernel_launch: bad shapes: n_in %d ws %zu out %d\n", n_in, ws_size, out_size); grid = -1; return; }
        int dev = 0, cus = 0, per_cu = 0;
        if (hipGetDevice(&dev) != hipSuccess || hipDeviceGetAttribute(&cus, hipDeviceAttributeMultiprocessorCount, dev) != hipSuccess) { grid = -1; return; }
        if (hipFuncSetAttribute((const void*)mk_fwd, hipFuncAttributeMaxDynamicSharedMemorySize, LDS_BYTES) != hipSuccess) { fprintf(stderr, "kernel_launch: hipFuncSetAttribute failed\n"); grid = -1; return; }
        if (hipOccupancyMaxActiveBlocksPerMultiprocessor(&per_cu, (const void*)mk_fwd, NWAVES * 64, LDS_BYTES) != hipSuccess || per_cu < 1) { fprintf(stderr, "kernel_launch: occupancy query says %d\n", per_cu); grid = -1; return; }
        grid = cus;
    }
    if (grid < 0) return;
    Args a{};
    for (int i = 0; i < 25; ++i) a.in[i] = (const float*)d_in[i];
    a.out = (float*)d_out; a.ws = (unsigned char*)d_ws;
    a.ph_lo = 0; a.ph_hi = PH_N; a.layer = 0; a.pad = DEPTH;
    if (hipMemsetAsync((char*)d_ws + WS_CTL, 0, CTL_BYTES, stream) != hipSuccess) { fprintf(stderr, "kernel_launch: memset failed\n"); return; }
    void* kargs[] = {&a};
    const hipError_t e = hipLaunchCooperativeKernel((const void*)mk_fwd, dim3(grid), dim3(NWAVES * 64), kargs, LDS_BYTES, stream);
    if (e != hipSuccess) fprintf(stderr, "kernel_launch: cooperative launch failed: %s (grid %d)\n", hipGetErrorString(e), grid);
}
```

```cpp
#include <hip/hip_runtime.h>
#include <hip/hip_cooperative_groups.h>
namespace cg = cooperative_groups;
#include <cstdio>
#include <cstdint>
#include <cstddef>

constexpr int DM = 2048, NBATCH = 2, SEQ = 4096, T = NBATCH * SEQ, DEPTH = 2, GW_ = 64;
constexpr int INC = 6208, NEXP = 16384;
constexpr float EPS = 1e-6f;
constexpr int NA_N = 12544;
constexpr float NA_SCALE = 0.08838834764831845f, MLA_SCALE = 0.07216878364870322f;

typedef unsigned short bf16_t;
typedef short bf16x8 __attribute__((ext_vector_type(8)));
typedef float f32x4 __attribute__((ext_vector_type(4)));
typedef float f32x2 __attribute__((ext_vector_type(2)));
typedef unsigned u32x4 __attribute__((ext_vector_type(4)));
typedef unsigned u32x2 __attribute__((ext_vector_type(2)));
typedef int i32x4_t __attribute__((ext_vector_type(4)));
#define LAS __attribute__((address_space(3)))

constexpr size_t MiB = 1u << 20;
constexpr size_t WS_CTL = 0, WS_ROPE = 1 * MiB, WS_W = 2 * MiB, WL_STRIDE = 210 * MiB;
constexpr size_t WO_WA = 0, WO_WUQ = 49 * MiB, WO_WUKV = WO_WUQ + 3 * MiB / 2, WO_WBR = WO_WUKV + 2 * MiB, WO_WOUT = WO_WBR + 12 * MiB, WO_WQ = WO_WOUT + 8 * MiB,
                 WO_KEYS = WO_WQ + 8 * MiB, WO_SGUW = WO_KEYS + MiB / 2, WO_PU = WO_SGUW + MiB / 4, WO_PV = WO_PU + 64 * MiB, WO_KLO = WO_PV + 64 * MiB;
static_assert(WO_KLO + MiB / 2 <= WL_STRIDE, "weight map");
constexpr size_t WS_X = 422 * MiB, WS_XB = 486 * MiB, WS_QA = 518 * MiB, WS_KA = 534 * MiB, WS_VA = 550 * MiB, WS_ZB = 566 * MiB, WS_CQ = 598 * MiB, WS_CKV = 606 * MiB,
                 WS_KR = 614 * MiB, WS_GATES = 616 * MiB, WS_QF = 712 * MiB, WS_KF = 736 * MiB, WS_VF = 760 * MiB, WS_OCAT = 776 * MiB, WS_MERGED = 824 * MiB, WS_PQ = 856 * MiB  , WS_ZST = 898 * MiB  , WS_PART = 856 * MiB  , WS_SC = WS_QF  ,
                 WS_IDX = 888 * MiB, WS_GW = 892 * MiB, WS_CQSS = 896 * MiB, WS_CKVSS = WS_CQSS + MiB / 4, WS_XSS = WS_CQSS + MiB / 2, WS_RS = WS_XSS + MiB, WS_RS2 = WS_RS + 32768,
                 WS_XQ = 900 * MiB  , WS_WGQ = 916 * MiB  , WS_SA = 970 * MiB  , WS_SB = WS_SA + 65536  ,
                 WS_END = 972 * MiB;
constexpr size_t CTL_CMAX = 65536;
constexpr size_t CTL_BYTES = 65536;

__device__ __forceinline__ float bf2f(unsigned v) { return __uint_as_float(v << 16); }
typedef __bf16 bf16x2_t __attribute__((ext_vector_type(2)));
typedef float f32x2_t __attribute__((ext_vector_type(2)));
__device__ __forceinline__ unsigned cvt_pk_bf16(float lo, float hi) { const f32x2_t v = {lo, hi}; return __builtin_bit_cast(unsigned, __builtin_convertvector(v, bf16x2_t)); }
__device__ __forceinline__ unsigned f2bf(float f) { return cvt_pk_bf16(f, 0.f) & 0xffffu; }
__device__ __forceinline__ float fast_tanh(float y) { const float e = __builtin_amdgcn_exp2f(y * 2.8853900817779268f); return 1.f - 2.f * __builtin_amdgcn_rcpf(1.f + e); }
__device__ __forceinline__ float gelu_tanh(float x) { return 0.5f * x * (1.f + fast_tanh(0.7978845608028654f * (x + 0.044715f * x * x * x))); }
__device__ __forceinline__ float sigmoidf_(float z) { return __builtin_amdgcn_rcpf(1.f + __builtin_amdgcn_exp2f(-1.4426950408889634f * z)); }
__device__ __forceinline__ float wave_sum(float v) {
#pragma unroll
    for (int o = 1; o < 64; o <<= 1) v += __shfl_xor(v, o);
    return v;
}

__device__ __forceinline__ int otid(int wave_s) { int t; asm volatile("v_mbcnt_lo_u32_b32 %0, -1, 0\n\tv_mbcnt_hi_u32_b32 %0, -1, %0" : "=&v"(t)); return (wave_s << 6) | t; }
namespace pg8 {
constexpr int BM = 256, BK = 64, HALF = 128, HTB = HALF * BK * 2, STAGE_BYTES = 8 * HTB, NXCD = 8, WGM = 8;
__host__ __device__ __forceinline__ int lds_byte(int r, int c) { const int st = (r >> 4) * 2 + (c >> 5), rr = r & 15, cc = c & 31, ob = rr * 64 + cc * 2; return st * 1024 + (ob ^ (((ob >> 9) & 1) << 5)); }
__host__ __device__ __forceinline__ void stage_rc(int b, int& R, int& C) { const int st = b / 1024, sb = b % 1024, swz = sb ^ (((sb >> 9) & 1) << 5); R = (st >> 1) * 16 + swz / 64; C = (st & 1) * 32 + (swz % 64) / 2; }
__host__ __device__ __forceinline__ int perm32(int rho) { const int n = rho >> 4, i = rho & 15; return 8 * (i >> 2) + 4 * n + (i & 3); }
struct Unit { int pm, pn; };
struct Gemm { const bf16_t* A; const bf16_t* Bt; int M, N, K; long dA2 = 0; int split = 0x7fffffff; };
struct StaticOrder {
    int nM, nN, nwg, G, c;
    __host__ __device__ void init(int M, int N, int G_, int c_) { nM = M / BM; nN = N / BM; nwg = nM * nN; G = G_; c = c_; }
    __host__ __device__ bool next(int i, Unit& u) const {
        const long L = (long)i * G + c; if (L >= nwg) return false;
        int wgid = (int)L; { const int q = nwg / NXCD, r = nwg % NXCD, xcd = wgid % NXCD, off = wgid / NXCD; wgid = (xcd < r ? xcd * (q + 1) : r * (q + 1) + (xcd - r) * q) + off; }
        const int nig = WGM * nN, gid = wgid / nig, fm = gid * WGM, gsz = (nM - fm) < WGM ? (nM - fm) : WGM;
        u.pm = fm + ((wgid % nig) % gsz); u.pn = (wgid % nig) / gsz; return true;
    }
};
typedef int i32x4 __attribute__((ext_vector_type(4)));
template <bool I8> struct AccSel { typedef f32x4 T; };
template <> struct AccSel<true> { typedef i32x4 T; };
__device__ __forceinline__ f32x4 mma1(bf16x8 a, bf16x8 b, f32x4 c) { return __builtin_amdgcn_mfma_f32_16x16x32_bf16(a, b, c, 0, 0, 0); }
__device__ __forceinline__ i32x4 mma1(bf16x8 a, bf16x8 b, i32x4 c) { return __builtin_amdgcn_mfma_i32_16x16x64_i8(__builtin_bit_cast(i32x4, a), __builtin_bit_cast(i32x4, b), c, 0, 0, 0); }
template <class Epi, class Sched, bool ALIGN_EPI = false, bool SP2 = false, bool I8 = false>
__device__ __forceinline__ void gemm_phase(LAS unsigned char* lds, const Gemm g, const Sched& S, const Epi& E, const int tid) {
    const int wid = __builtin_amdgcn_readfirstlane(tid >> 6), lane = tid & 63, wr = wid >> 2, wc = wid & 3, fr = lane & 15, fq = lane >> 4;
    const int K = g.K, nt = K / BK;
    unsigned voffA[2], voffB[2];
#pragma unroll
    for (int i = 0; i < 2; ++i) { int R, C; stage_rc(tid * 16 + i * 8192, R, C); const int Rb = Epi::PERM ? ((R & ~31) + perm32(R & 31)) : R;
        voffA[i] = (unsigned)(R * K + C) * 2u; voffB[i] = (unsigned)(Rb * K + C) * 2u; }
    const size_t kstep = (size_t)(BK * 2);
    const size_t hstep = (size_t)HALF * K * 2;
    const size_t tstep = 2 * hstep;
    const unsigned ldsw = (unsigned)wid * 1024u;
    const int aoff = lds_byte(wr * 64 + fr, fq * 8), boff = lds_byte(wc * 32 + fr, fq * 8);
#define PG8_SA(b, h) (((b) * 2 + (h)) * HTB)
#define PG8_SB(b, h) ((4 + (b) * 2 + (h)) * HTB)
#define PG8_STAGE(bufoff, gbase, voff) do { _Pragma("unroll") for (int _i = 0; _i < 2; ++_i) \
        __builtin_amdgcn_global_load_lds((const unsigned*)((const char*)(gbase) + (voff)[_i]), (LAS unsigned*)(lds + (bufoff) + ldsw + _i * 8192), 16, 0, 0); } while (0)
#define PG8_LDA(dst, b, h) do { _Pragma("unroll") for (int m = 0; m < 4; ++m) _Pragma("unroll") for (int k = 0; k < 2; ++k) dst[m][k] = *(const LAS bf16x8*)(lds + PG8_SA(b, h) + aoff + m * 2048 + k * 1024); } while (0)
#define PG8_LDB(dst, b, h) do { _Pragma("unroll") for (int n = 0; n < 2; ++n) _Pragma("unroll") for (int k = 0; k < 2; ++k) dst[n][k] = *(const LAS bf16x8*)(lds + PG8_SB(b, h) + boff + n * 2048 + k * 1024); } while (0)
#define PG8_MMA(ai, bj, At, Bt) do { __builtin_amdgcn_s_setprio(1); _Pragma("unroll") for (int m = 0; m < 4; ++m) _Pragma("unroll") for (int n = 0; n < 2; ++n) _Pragma("unroll") for (int k = 0; k < 2; ++k) \
        acc[ai][bj][m][n] = mma1(Bt[n][k], At[m][k], acc[ai][bj][m][n]); __builtin_amdgcn_s_setprio(0); } while (0)
#define PG8_WAIT_V(n) asm volatile("s_waitcnt vmcnt(" #n ")" ::: "memory")
#define PG8_WAIT_L(n) asm volatile("s_waitcnt lgkmcnt(" #n ")" ::: "memory")
#define PG8_BAR __builtin_amdgcn_s_barrier()
#define PG8_SCHED __builtin_amdgcn_sched_barrier(0)
    Unit cur, nxt; int ui = 0;
    if (!S.next(0, cur)) return;
    typedef typename AccSel<I8>::T acc_t; acc_t acc[2][2][4][2];
#pragma unroll
    for (int a = 0; a < 2; ++a)
#pragma unroll
        for (int b = 0; b < 2; ++b)
#pragma unroll
            for (int m = 0; m < 4; ++m)
#pragma unroll
                for (int n = 0; n < 2; ++n) acc[a][b][m][n] = acc_t{};
    bf16x8 At[4][2], B0[2][2], B1[2][2];
    const char* cA = (const char*)g.A + (cur.pn >= g.split ? g.dA2 : 0L) + (size_t)cur.pm * tstep; const char* cB = (const char*)g.Bt + (size_t)cur.pn * tstep;
    if constexpr (SP2) {
        PG8_STAGE(PG8_SB(0, 0), cB, voffB); PG8_STAGE(PG8_SB(0, 1), cB + hstep, voffB); PG8_STAGE(PG8_SA(0, 0), cA, voffA); PG8_STAGE(PG8_SA(0, 1), cA + hstep, voffA);
        if (wr == 1) PG8_BAR;
        PG8_WAIT_V(2); PG8_BAR;
        PG8_STAGE(PG8_SB(1, 0), cB + kstep, voffB); PG8_STAGE(PG8_SA(1, 0), cA + kstep, voffA); PG8_STAGE(PG8_SB(1, 1), cB + hstep + kstep, voffB);
        PG8_WAIT_V(6); PG8_BAR;
    } else {
        PG8_STAGE(PG8_SB(0, 0), cB, voffB); PG8_STAGE(PG8_SA(0, 0), cA, voffA); PG8_STAGE(PG8_SB(0, 1), cB + hstep, voffB); PG8_STAGE(PG8_SA(0, 1), cA + hstep, voffA);
        if (wr == 1) PG8_BAR;
        PG8_WAIT_V(4); PG8_BAR;
        PG8_STAGE(PG8_SB(1, 0), cB + kstep, voffB); PG8_STAGE(PG8_SA(1, 0), cA + kstep, voffA); PG8_STAGE(PG8_SB(1, 1), cB + hstep + kstep, voffB);
        PG8_WAIT_V(6); PG8_BAR;
    }
    for (;;) {
        const bool has_next = S.next(ui + 1, nxt);
        const char* nA = has_next ? (const char*)g.A + (nxt.pn >= g.split ? g.dA2 : 0L) + (size_t)nxt.pm * tstep : cA; const char* nB = has_next ? (const char*)g.Bt + (size_t)nxt.pn * tstep : cB;
        for (int t = 0; t < nt; t += 2) {
            if constexpr (Epi::KHOOK) { if (t == 16 || t == 32) E.khook(acc, cur, t >> 4, wr, wc, fr, fq); }
            const bool last = (t == nt - 2);
            const char* a1 = cA + (size_t)(t + 1) * kstep;
            const char* a2 = last ? nA : cA + (size_t)(t + 2) * kstep; const char* b2 = last ? nB : cB + (size_t)(t + 2) * kstep;
            const char* a3 = a2 + kstep; const char* b3 = b2 + kstep;
            if constexpr (SP2) {
            PG8_LDB(B0, 0, 0); PG8_LDB(B1, 0, 1); PG8_SCHED; PG8_LDA(At, 0, 0); PG8_STAGE(PG8_SA(1, 1), a1 + hstep, voffA);
            PG8_WAIT_V(8); PG8_WAIT_L(0); PG8_BAR; PG8_MMA(0, 0, At, B0); PG8_MMA(0, 1, At, B1); PG8_BAR; PG8_SCHED;
            PG8_LDA(At, 0, 1); PG8_STAGE(PG8_SB(0, 0), b2, voffB); PG8_STAGE(PG8_SB(0, 1), b2 + hstep, voffB); PG8_STAGE(PG8_SA(0, 0), a2, voffA);
            PG8_WAIT_V(8); PG8_WAIT_L(0); PG8_BAR; PG8_MMA(1, 0, At, B0); PG8_MMA(1, 1, At, B1); PG8_BAR; PG8_SCHED;
            PG8_LDB(B0, 1, 0); PG8_LDB(B1, 1, 1); PG8_SCHED; PG8_LDA(At, 1, 0); PG8_STAGE(PG8_SA(0, 1), a2 + hstep, voffA);
            PG8_WAIT_V(8); PG8_WAIT_L(0); PG8_BAR; PG8_MMA(0, 0, At, B0); PG8_MMA(0, 1, At, B1); PG8_BAR; PG8_SCHED;
            PG8_LDA(At, 1, 1); PG8_STAGE(PG8_SB(1, 0), b3, voffB); PG8_STAGE(PG8_SB(1, 1), b3 + hstep, voffB); PG8_STAGE(PG8_SA(1, 0), a3, voffA);
            PG8_WAIT_V(8); PG8_WAIT_L(0); PG8_BAR; PG8_MMA(1, 0, At, B0); PG8_MMA(1, 1, At, B1); PG8_BAR; PG8_SCHED;
            } else {
            PG8_LDB(B0, 0, 0); PG8_SCHED; PG8_LDA(At, 0, 0); PG8_STAGE(PG8_SA(1, 1), a1 + hstep, voffA);
            PG8_WAIT_L(8); PG8_BAR; PG8_WAIT_L(0); PG8_MMA(0, 0, At, B0); PG8_BAR; PG8_SCHED;
            PG8_LDB(B1, 0, 1); PG8_STAGE(PG8_SB(0, 0), b2, voffB);
            PG8_BAR; PG8_WAIT_L(0); PG8_MMA(0, 1, At, B1); PG8_BAR;
            PG8_LDA(At, 0, 1); PG8_STAGE(PG8_SA(0, 0), a2, voffA);
            PG8_BAR; PG8_WAIT_L(0); PG8_MMA(1, 0, At, B0); PG8_BAR; PG8_SCHED;
            PG8_STAGE(PG8_SB(0, 1), b2 + hstep, voffB);
            PG8_WAIT_V(6); PG8_BAR; PG8_MMA(1, 1, At, B1); PG8_BAR;
            PG8_LDB(B0, 1, 0); PG8_SCHED; PG8_LDA(At, 1, 0); PG8_STAGE(PG8_SA(0, 1), a2 + hstep, voffA);
            PG8_WAIT_L(8); PG8_BAR; PG8_WAIT_L(0); PG8_MMA(0, 0, At, B0); PG8_BAR; PG8_SCHED;
            PG8_LDB(B1, 1, 1); PG8_STAGE(PG8_SB(1, 0), b3, voffB);
            PG8_BAR; PG8_WAIT_L(0); PG8_MMA(0, 1, At, B1); PG8_BAR;
            PG8_LDA(At, 1, 1); PG8_STAGE(PG8_SA(1, 0), a3, voffA);
            PG8_BAR; PG8_WAIT_L(0); PG8_MMA(1, 0, At, B0); PG8_BAR; PG8_SCHED;
            PG8_STAGE(PG8_SB(1, 1), b3 + hstep, voffB);
            PG8_WAIT_V(6); PG8_BAR; PG8_MMA(1, 1, At, B1); PG8_BAR;
            }
        }
        if constexpr (ALIGN_EPI) { if (wr == 0) PG8_BAR; }
        E(acc, cur, wr, wc, fr, fq);
        if (!has_next) break;
#pragma unroll
        for (int a = 0; a < 2; ++a)
#pragma unroll
            for (int b = 0; b < 2; ++b)
#pragma unroll
                for (int m = 0; m < 4; ++m)
#pragma unroll
                    for (int n = 0; n < 2; ++n) acc[a][b][m][n] = acc_t{};
        cur = nxt; cA = nA; cB = nB; ++ui;
        if constexpr (ALIGN_EPI) { if (wr == 1) PG8_BAR; }
    }
    PG8_WAIT_V(0);
    if constexpr (!ALIGN_EPI) { if (wr == 0) PG8_BAR; }
    PG8_BAR;
#undef PG8_SA
#undef PG8_SB
#undef PG8_STAGE
#undef PG8_LDA
#undef PG8_LDB
#undef PG8_MMA
#undef PG8_WAIT_V
#undef PG8_WAIT_L
#undef PG8_BAR
#undef PG8_SCHED
}
}
using pg8::Unit;
typedef const f32x4 (&AccRef)[2][2][4][2];

__device__ __forceinline__ void store8_bf16(bf16_t* p, f32x4 v0, f32x4 v1) {
    u32x4 w; w.x = cvt_pk_bf16(v0[0], v0[1]); w.y = cvt_pk_bf16(v0[2], v0[3]); w.z = cvt_pk_bf16(v1[0], v1[1]); w.w = cvt_pk_bf16(v1[2], v1[3]); *(u32x4*)p = w;
}
__device__ __forceinline__ unsigned long long opaque_u64(unsigned long long v_) { unsigned lo_ = __builtin_amdgcn_readfirstlane((unsigned)v_), hi_ = __builtin_amdgcn_readfirstlane((unsigned)(v_ >> 32));
    asm volatile("" : "+s"(lo_), "+s"(hi_)); return ((unsigned long long)hi_ << 32) | lo_; }
struct EpiA {
    static constexpr bool PERM = true, KHOOK = false;
    unsigned char* ws_; const float* bgate_;
    __device__ __forceinline__ void khook(f32x4 (&)[2][2][4][2], const Unit&, int, int, int, int, int) const {}
    __device__ __forceinline__ void operator()(AccRef acc, const Unit& u, int wr, int wc, int fr, int fq) const {
        const int pn = u.pn, row0 = u.pm * 256 + wr * 64 + fr, ct = wc * 32 + 8 * fq;
        unsigned char* ws = ws_; const float* bgate = bgate_;
        const float* rs = (const float*)(ws + WS_RS);
        if (pn < 12) {
            bf16_t* base = (bf16_t*)(ws + (pn < 4 ? WS_QA : (pn < 8 ? WS_KA : WS_VA))) + (pn & 3) * 256 + ct; const float sc0 = pn < 4 ? NA_SCALE : 1.f;
#pragma unroll
            for (int ai = 0; ai < 2; ++ai)
#pragma unroll
                for (int m = 0; m < 4; ++m) { const int row = row0 + ai * 128 + m * 16; const float sc = rs[row] * sc0;
#pragma unroll
                    for (int bj = 0; bj < 2; ++bj) store8_bf16(base + (size_t)row * 1024 + bj * 128, acc[ai][bj][m][0] * sc, acc[ai][bj][m][1] * sc); }
        } else if (pn < 20) {
            bf16_t* base = (bf16_t*)(ws + WS_ZB) + (pn - 12) * 256 + ct;
#pragma unroll
            for (int ai = 0; ai < 2; ++ai)
#pragma unroll
                for (int m = 0; m < 4; ++m) { const int row = row0 + ai * 128 + m * 16; const float r = rs[row];
#pragma unroll
                    for (int bj = 0; bj < 2; ++bj) { f32x4 v0 = acc[ai][bj][m][0] * r, v1 = acc[ai][bj][m][1] * r;
#pragma unroll
                        for (int i = 0; i < 4; ++i) { v0[i] = gelu_tanh(v0[i]); v1[i] = gelu_tanh(v1[i]); }
                        store8_bf16(base + (size_t)row * 2048 + bj * 128, v0, v1); } }
        } else if (pn < 24) {
            const int half = (pn - 20) & 1; bf16_t* base = (bf16_t*)(ws + (pn < 22 ? WS_CQ : WS_CKV)) + half * 256 + ct; float* ss = (float*)(ws + (pn < 22 ? WS_CQSS : WS_CKVSS)) + half * 4 + wc;
#pragma unroll
            for (int ai = 0; ai < 2; ++ai)
#pragma unroll
                for (int m = 0; m < 4; ++m) { const int row = row0 + ai * 128 + m * 16; const float r = rs[row]; float s = 0.f;
#pragma unroll
                    for (int bj = 0; bj < 2; ++bj) { const f32x4 v0 = acc[ai][bj][m][0] * r, v1 = acc[ai][bj][m][1] * r;
                        s += (v0[0] * v0[0] + v0[1] * v0[1]) + (v0[2] * v0[2] + v0[3] * v0[3]) + (v1[0] * v1[0] + v1[1] * v1[1]) + (v1[2] * v1[2] + v1[3] * v1[3]);
                        store8_bf16(base + (size_t)row * 512 + bj * 128, v0, v1); }
                    s += __shfl_xor(s, 16); s += __shfl_xor(s, 32);
                    if (fq == 0) ss[(size_t)row * 8] = s; }
        } else if (pn < 48) {
            const int c0 = (pn - 24) * 256 + ct; bf16_t* base = (bf16_t*)(ws + WS_GATES) + c0;
            const f32x4 b00 = *(const f32x4*)(bgate + c0), b01 = *(const f32x4*)(bgate + c0 + 4), b10 = *(const f32x4*)(bgate + c0 + 128), b11 = *(const f32x4*)(bgate + c0 + 132);
#pragma unroll
            for (int ai = 0; ai < 2; ++ai)
#pragma unroll
                for (int m = 0; m < 4; ++m) { const int row = row0 + ai * 128 + m * 16; const float r = rs[row];
#pragma unroll
                    for (int bj = 0; bj < 2; ++bj) { f32x4 v0 = acc[ai][bj][m][0] * r + (bj ? b10 : b00), v1 = acc[ai][bj][m][1] * r + (bj ? b11 : b01);
#pragma unroll
                        for (int i = 0; i < 4; ++i) { v0[i] = sigmoidf_(v0[i]); v1[i] = sigmoidf_(v1[i]); }
                        store8_bf16(base + (size_t)row * 6144 + bj * 128, v0, v1); } }
        }
    }
};
__device__ __forceinline__ unsigned q8(float v) { int i = (int)__builtin_rintf(v); i = i < -127 ? -127 : (i > 127 ? 127 : i); return (unsigned)i & 255u; }
__device__ __forceinline__ unsigned pack4_q8(float a, float b, float c, float d) { return q8(a) | (q8(b) << 8) | (q8(c) << 16) | (q8(d) << 24); }
struct EpiA8 {
    static constexpr bool PERM = true, KHOOK = false;
    unsigned char* ws_; const float* bgate_; const float* sb_;
    __device__ __forceinline__ void khook(i32x4_t (&)[2][2][4][2], const Unit&, int, int, int, int, int) const {}
    __device__ __forceinline__ void operator()(const i32x4_t (&acc)[2][2][4][2], const Unit& u, int wr, int wc, int fr, int fq) const {
        unsigned char* ws = (unsigned char*)opaque_u64((unsigned long long)ws_); const float* bgate = (const float*)opaque_u64((unsigned long long)bgate_); const float* sb = (const float*)opaque_u64((unsigned long long)sb_);
        const float* rs = (const float*)(ws + WS_RS); const float* sa = (const float*)(ws + WS_SA);
        const int pn = u.pn, row0 = u.pm * 256 + wr * 64 + fr, ct = wc * 32 + 8 * fq;
        f32x4 ss[2][2];
#pragma unroll
        for (int bj = 0; bj < 2; ++bj)
#pragma unroll
            for (int n = 0; n < 2; ++n) ss[bj][n] = *(const f32x4*)(sb + pn * 256 + ct + bj * 128 + 4 * n);
#define A8F(ai, bj, m, n) __builtin_convertvector(acc[ai][bj][m][n], f32x4)
        if (pn < 12) {
            bf16_t* base = (bf16_t*)(ws + (pn < 4 ? WS_QA : (pn < 8 ? WS_KA : WS_VA))) + (pn & 3) * 256 + ct; const float sc0 = pn < 4 ? NA_SCALE : 1.f;
#pragma unroll
            for (int ai = 0; ai < 2; ++ai)
#pragma unroll
                for (int m = 0; m < 4; ++m) { const int row = row0 + ai * 128 + m * 16; const float sc = rs[row] * sa[row] * sc0;
#pragma unroll
                    for (int bj = 0; bj < 2; ++bj) store8_bf16(base + (size_t)row * 1024 + bj * 128, A8F(ai, bj, m, 0) * (ss[bj][0] * sc), A8F(ai, bj, m, 1) * (ss[bj][1] * sc)); }
        } else if (pn < 20) {
            bf16_t* base = (bf16_t*)(ws + WS_ZB) + (pn - 12) * 256 + ct; float* zst = (float*)(ws + WS_ZST) + ((pn - 16) & 3) * 8 + wc * 2;
#pragma unroll
            for (int ai = 0; ai < 2; ++ai)
#pragma unroll
                for (int m = 0; m < 4; ++m) { const int row = row0 + ai * 128 + m * 16; const float r = rs[row] * sa[row]; float s1 = 0.f, s2 = 0.f;
#pragma unroll
                    for (int bj = 0; bj < 2; ++bj) { f32x4 v0 = A8F(ai, bj, m, 0) * (ss[bj][0] * r), v1 = A8F(ai, bj, m, 1) * (ss[bj][1] * r);
#pragma unroll
                        for (int i = 0; i < 4; ++i) { v0[i] = gelu_tanh(v0[i]); v1[i] = gelu_tanh(v1[i]); }
                        s1 += ((v0[0] + v0[1]) + (v0[2] + v0[3])) + ((v1[0] + v1[1]) + (v1[2] + v1[3]));
                        s2 += ((v0[0] * v0[0] + v0[1] * v0[1]) + (v0[2] * v0[2] + v0[3] * v0[3])) + ((v1[0] * v1[0] + v1[1] * v1[1]) + (v1[2] * v1[2] + v1[3] * v1[3]));
                        store8_bf16(base + (size_t)row * 2048 + bj * 128, v0, v1); }
                    if (pn >= 16) { s1 += __shfl_xor(s1, 16); s1 += __shfl_xor(s1, 32); s2 += __shfl_xor(s2, 16); s2 += __shfl_xor(s2, 32);
                        if (fq == 0) *(f32x2*)(zst + (size_t)row * 32) = (f32x2){s1, s2}; } }
        } else if (pn < 24) {
            const int half = (pn - 20) & 1; bf16_t* base = (bf16_t*)(ws + (pn < 22 ? WS_CQ : WS_CKV)) + half * 256 + ct; float* sq = (float*)(ws + (pn < 22 ? WS_CQSS : WS_CKVSS)) + half * 4 + wc;
#pragma unroll
            for (int ai = 0; ai < 2; ++ai)
#pragma unroll
                for (int m = 0; m < 4; ++m) { const int row = row0 + ai * 128 + m * 16; const float r = rs[row] * sa[row]; float s = 0.f;
#pragma unroll
                    for (int bj = 0; bj < 2; ++bj) { const f32x4 v0 = A8F(ai, bj, m, 0) * (ss[bj][0] * r), v1 = A8F(ai, bj, m, 1) * (ss[bj][1] * r);
                        s += (v0[0] * v0[0] + v0[1] * v0[1]) + (v0[2] * v0[2] + v0[3] * v0[3]) + (v1[0] * v1[0] + v1[1] * v1[1]) + (v1[2] * v1[2] + v1[3] * v1[3]);
                        store8_bf16(base + (size_t)row * 512 + bj * 128, v0, v1); }
                    s += __shfl_xor(s, 16); s += __shfl_xor(s, 32);
                    if (fq == 0) sq[(size_t)row * 8] = s; }
        } else {
            const int c0 = (pn - 24) * 256 + ct; bf16_t* base = (bf16_t*)(ws + WS_GATES) + c0;
            f32x4 bb[2][2];
#pragma unroll
            for (int bj = 0; bj < 2; ++bj)
#pragma unroll
                for (int n = 0; n < 2; ++n) bb[bj][n] = *(const f32x4*)(bgate + c0 + bj * 128 + 4 * n);
#pragma unroll
            for (int ai = 0; ai < 2; ++ai)
#pragma unroll
                for (int m = 0; m < 4; ++m) { const int row = row0 + ai * 128 + m * 16; const float r = rs[row] * sa[row];
#pragma unroll
                    for (int bj = 0; bj < 2; ++bj) { f32x4 v0 = A8F(ai, bj, m, 0) * (ss[bj][0] * r) + bb[bj][0], v1 = A8F(ai, bj, m, 1) * (ss[bj][1] * r) + bb[bj][1];
#pragma unroll
                        for (int i = 0; i < 4; ++i) { v0[i] = sigmoidf_(v0[i]); v1[i] = sigmoidf_(v1[i]); }
                        store8_bf16(base + (size_t)row * 6144 + bj * 128, v0, v1); } }
        }
#undef A8F
    }
};
struct EpiQup; struct EpiKVup;
struct EpiQup {
    static constexpr bool PERM = true, KHOOK = false;
    const float* ss; const f32x2* rope; bf16_t* QF;
    __device__ __forceinline__ void khook(f32x4 (&)[2][2][4][2], const Unit&, int, int, int, int, int) const {}
    __device__ __forceinline__ void operator()(AccRef acc, const Unit& u, int wr, int wc, int fr, int fq) const {
        const int row0 = u.pm * 256 + wr * 64 + fr, ct = u.pn * 256 + wc * 32 + 8 * fq;
#pragma unroll
        for (int ai = 0; ai < 2; ++ai)
#pragma unroll
            for (int m = 0; m < 4; ++m) {
                const int row = row0 + ai * 128 + m * 16;
                const f32x4 s0 = *(const f32x4*)(ss + (size_t)row * 8), s1 = *(const f32x4*)(ss + (size_t)row * 8 + 4);
                const float r = rsqrtf(((s0[0] + s0[1]) + (s0[2] + s0[3]) + (s1[0] + s1[1]) + (s1[2] + s1[3])) * (1.f / 512.f) + EPS);
#pragma unroll
                for (int bj = 0; bj < 2; ++bj) { const int col = ct + bj * 128, off = col % 192; f32x4 v0 = acc[ai][bj][m][0] * r, v1 = acc[ai][bj][m][1] * r;
                    if (off >= 128) { const int i0 = (off - 128) >> 1; const f32x2* rp = rope + (size_t)(row & (SEQ - 1)) * 32 + i0;
                        const f32x2 c0 = rp[0], c1 = rp[1], c2 = rp[2], c3 = rp[3];
                        const f32x4 a = v0, b = v1;
                        v0[0] = a[0] * c0.x - a[1] * c0.y; v0[1] = a[1] * c0.x + a[0] * c0.y; v0[2] = a[2] * c1.x - a[3] * c1.y; v0[3] = a[3] * c1.x + a[2] * c1.y;
                        v1[0] = b[0] * c2.x - b[1] * c2.y; v1[1] = b[1] * c2.x + b[0] * c2.y; v1[2] = b[2] * c3.x - b[3] * c3.y; v1[3] = b[3] * c3.x + b[2] * c3.y; }
                    store8_bf16(QF + (size_t)row * 1536 + col, v0, v1); }
            }
    }
};
struct EpiKVup {
    static constexpr bool PERM = true, KHOOK = false;
    const float* ss; bf16_t *KF, *VF;
    __device__ __forceinline__ void khook(f32x4 (&)[2][2][4][2], const Unit&, int, int, int, int, int) const {}
    __device__ __forceinline__ void operator()(AccRef acc, const Unit& u, int wr, int wc, int fr, int fq) const {
        const int row0 = u.pm * 256 + wr * 64 + fr, ct = wc * 32 + 8 * fq, h = u.pn;
#pragma unroll
        for (int ai = 0; ai < 2; ++ai)
#pragma unroll
            for (int m = 0; m < 4; ++m) {
                const int row = row0 + ai * 128 + m * 16;
                const f32x4 s0 = *(const f32x4*)(ss + (size_t)row * 8), s1 = *(const f32x4*)(ss + (size_t)row * 8 + 4);
                const float r = rsqrtf(((s0[0] + s0[1]) + (s0[2] + s0[3]) + (s1[0] + s1[1]) + (s1[2] + s1[3])) * (1.f / 512.f) + EPS);
                store8_bf16(KF + (size_t)row * 1536 + h * 192 + ct, acc[ai][0][m][0] * r, acc[ai][0][m][1] * r);
                store8_bf16(VF + (size_t)row * 1024 + h * 128 + ct, acc[ai][1][m][0] * r, acc[ai][1][m][1] * r);
            }
    }
};
struct EpiUp {
    static constexpr bool PERM = true, KHOOK = false;
    EpiQup q; EpiKVup kv;
    __device__ __forceinline__ void khook(f32x4 (&)[2][2][4][2], const Unit&, int, int, int, int, int) const {}
    __device__ __forceinline__ void operator()(AccRef acc, const Unit& u, int wr, int wc, int fr, int fq) const {
        if (u.pn < 6) q(acc, u, wr, wc, fr, fq); else { const Unit u2{u.pm, u.pn - 6}; kv(acc, u2, wr, wc, fr, fq); }
    }
};
struct EpiMerge {
    static constexpr bool PERM = true, KHOOK = true;
    const bf16_t* GATES; bf16_t* MERGED;
    static __device__ __forceinline__ float rat(unsigned p, unsigned n) { return bf2f(p) * __builtin_amdgcn_rcpf(fmaxf(bf2f(n), 1e-30f)); }
    __device__ __forceinline__ void khook(f32x4 (&acc)[2][2][4][2], const Unit& u, int br, int wr, int wc, int fr, int fq) const {
        const bf16_t* gp = GATES + (size_t)(u.pm * 256 + wr * 64 + fr) * 6144 + (br - 1) * 2048 + u.pn * 256 + wc * 32 + 8 * fq;
#pragma unroll
        for (int ai = 0; ai < 2; ++ai)
#pragma unroll
            for (int mh = 0; mh < 2; ++mh) { u32x4 gp_[2][2], gn_[2][2];
#pragma unroll
                for (int mm = 0; mm < 2; ++mm)
#pragma unroll
                    for (int bj = 0; bj < 2; ++bj) { const bf16_t* q = gp + (size_t)(ai * 128 + (2 * mh + mm) * 16) * 6144 + bj * 128; gp_[mm][bj] = *(const u32x4*)q; gn_[mm][bj] = *(const u32x4*)(q + 2048); }
                asm volatile("" ::: "memory");
#pragma unroll
                for (int mm = 0; mm < 2; ++mm)
#pragma unroll
                    for (int bj = 0; bj < 2; ++bj) { const u32x4 a = gp_[mm][bj], b = gn_[mm][bj]; f32x4 r0, r1;
                        r0[0] = rat(a[0] & 0xffffu, b[0] & 0xffffu); r0[1] = rat(a[0] >> 16, b[0] >> 16); r0[2] = rat(a[1] & 0xffffu, b[1] & 0xffffu); r0[3] = rat(a[1] >> 16, b[1] >> 16);
                        r1[0] = rat(a[2] & 0xffffu, b[2] & 0xffffu); r1[1] = rat(a[2] >> 16, b[2] >> 16); r1[2] = rat(a[3] & 0xffffu, b[3] & 0xffffu); r1[3] = rat(a[3] >> 16, b[3] >> 16);
                        acc[ai][bj][2 * mh + mm][0] *= r0; acc[ai][bj][2 * mh + mm][1] *= r1; }
                asm volatile("" ::: "memory"); }
    }
    __device__ __forceinline__ void operator()(AccRef acc, const Unit& u, int wr, int wc, int fr, int fq) const {
        const int row0 = u.pm * 256 + wr * 64 + fr, ct = u.pn * 256 + wc * 32 + 8 * fq;
#pragma unroll
        for (int ai = 0; ai < 2; ++ai)
#pragma unroll
            for (int mh = 0; mh < 2; ++mh) { u32x4 g_[2][2];
#pragma unroll
                for (int mm = 0; mm < 2; ++mm)
#pragma unroll
                    for (int bj = 0; bj < 2; ++bj) g_[mm][bj] = *(const u32x4*)(GATES + (size_t)(row0 + ai * 128 + (2 * mh + mm) * 16) * 6144 + 4096 + ct + bj * 128);
                asm volatile("" ::: "memory");
#pragma unroll
                for (int mm = 0; mm < 2; ++mm) { const int m = 2 * mh + mm, row = row0 + ai * 128 + m * 16;
#pragma unroll
                    for (int bj = 0; bj < 2; ++bj) { const u32x4 g = g_[mm][bj];
                        f32x4 v0 = acc[ai][bj][m][0], v1 = acc[ai][bj][m][1];
                        v0[0] *= fmaxf(bf2f(g[0] & 0xffffu), 1e-30f); v0[1] *= fmaxf(bf2f(g[0] >> 16), 1e-30f); v0[2] *= fmaxf(bf2f(g[1] & 0xffffu), 1e-30f); v0[3] *= fmaxf(bf2f(g[1] >> 16), 1e-30f);
                        v1[0] *= fmaxf(bf2f(g[2] & 0xffffu), 1e-30f); v1[1] *= fmaxf(bf2f(g[2] >> 16), 1e-30f); v1[2] *= fmaxf(bf2f(g[3] & 0xffffu), 1e-30f); v1[3] *= fmaxf(bf2f(g[3] >> 16), 1e-30f);
                        store8_bf16(MERGED + (size_t)row * 2048 + ct + bj * 128, v0, v1); } }
                asm volatile("" ::: "memory"); }
    }
};
template <bool B16> struct EpiOutT {
    static constexpr bool PERM = true, KHOOK = false;
    const float* base; bf16_t* XB; float* XSS;
    __device__ __forceinline__ void khook(f32x4 (&)[2][2][4][2], const Unit&, int, int, int, int, int) const {}
    __device__ __forceinline__ void operator()(AccRef acc, const Unit& u, int wr, int wc, int fr, int fq) const {
        const int row0 = u.pm * 256 + wr * 64 + fr, col0 = u.pn * 256 + wc * 32 + 8 * fq;
#pragma unroll
        for (int ai = 0; ai < 2; ++ai)
#pragma unroll
            for (int m = 0; m < 4; ++m) { const int row = row0 + ai * 128 + m * 16; const size_t off = (size_t)row * DM + col0; float s = 0.f;
#pragma unroll
                for (int bj = 0; bj < 2; ++bj) { f32x4 b0, b1;
                    if constexpr (B16) { const u32x4 w = *(const u32x4*)(XB + off + bj * 128); b0 = (f32x4){bf2f(w.x & 0xffffu), bf2f(w.x >> 16), bf2f(w.y & 0xffffu), bf2f(w.y >> 16)}; b1 = (f32x4){bf2f(w.z & 0xffffu), bf2f(w.z >> 16), bf2f(w.w & 0xffffu), bf2f(w.w >> 16)}; }
                    else { b0 = *(const f32x4*)(base + off + bj * 128); b1 = *(const f32x4*)(base + off + bj * 128 + 4); }
                    const f32x4 v0 = b0 + acc[ai][bj][m][0], v1 = b1 + acc[ai][bj][m][1];
                    store8_bf16(XB + off + bj * 128, v0, v1);
                    s += ((v0[0] * v0[0] + v0[1] * v0[1]) + (v0[2] * v0[2] + v0[3] * v0[3])) + ((v1[0] * v1[0] + v1[1] * v1[1]) + (v1[2] * v1[2] + v1[3] * v1[3])); }
                s += __shfl_xor(s, 16); s += __shfl_xor(s, 32);
                if (fq == 0) XSS[(size_t)row * 32 + u.pn * 4 + wc] = s; }
    }
};
struct EpiQuery {
    static constexpr bool PERM = true, KHOOK = false;
    const float* XSS; float* SC; float* RS2;
    __device__ __forceinline__ void khook(f32x4 (&)[2][2][4][2], const Unit&, int, int, int, int, int) const {}
    __device__ __forceinline__ void operator()(AccRef acc, const Unit& u, int wr, int wc, int fr, int fq) const {
        const int row0 = u.pm * 256 + wr * 64 + fr, ct = u.pn * 256 + wc * 32 + 8 * fq;
#pragma unroll
        for (int ai = 0; ai < 2; ++ai)
#pragma unroll
            for (int m = 0; m < 4; ++m) { const int row = row0 + ai * 128 + m * 16; float s = 0.f;
#pragma unroll
                for (int j = 0; j < 2; ++j) { const f32x4 v = *(const f32x4*)(XSS + (size_t)row * 32 + 8 * fq + 4 * j); s += (v[0] + v[1]) + (v[2] + v[3]); }
                s += __shfl_xor(s, 16); s += __shfl_xor(s, 32);
                const float r = rsqrtf(s * (1.f / DM) + EPS);
                if (u.pn == 0 && wc == 0 && fq == 0) RS2[row] = r;
#pragma unroll
                for (int bj = 0; bj < 2; ++bj) store8_bf16((bf16_t*)SC + (size_t)row * 2048 + ct + bj * 128, acc[ai][bj][m][0] * r, acc[ai][bj][m][1] * r); }
    }
};

__device__ __forceinline__ void convert_item(const float* src, bf16_t* dst, const float* scale, int lane) {
#pragma unroll
    for (int j = 0; j < 4; ++j) { const int e = (j * 64 + lane) * 8; f32x4 a = *(const f32x4*)(src + e), b = *(const f32x4*)(src + e + 4);
        if (scale) { a = a * *(const f32x4*)(scale + e); b = b * *(const f32x4*)(scale + e + 4); }
        store8_bf16(dst + e, a, b); }
}

__device__ __forceinline__ void convert_item_hilo(const float* src, bf16_t* dhi, bf16_t* dlo, int lane) {
#pragma unroll
    for (int j = 0; j < 4; ++j) { const int e = (j * 64 + lane) * 8; const f32x4 a = *(const f32x4*)(src + e), b = *(const f32x4*)(src + e + 4);
        u32x4 h; h.x = cvt_pk_bf16(a[0], a[1]); h.y = cvt_pk_bf16(a[2], a[3]); h.z = cvt_pk_bf16(b[0], b[1]); h.w = cvt_pk_bf16(b[2], b[3]); *(u32x4*)(dhi + e) = h;
        f32x4 ra, rb; ra[0] = a[0] - bf2f(h.x & 0xffffu); ra[1] = a[1] - bf2f(h.x >> 16); ra[2] = a[2] - bf2f(h.y & 0xffffu); ra[3] = a[3] - bf2f(h.y >> 16);
        rb[0] = b[0] - bf2f(h.z & 0xffffu); rb[1] = b[1] - bf2f(h.z >> 16); rb[2] = b[2] - bf2f(h.w & 0xffffu); rb[3] = b[3] - bf2f(h.w >> 16);
        store8_bf16(dlo + e, ra, rb); }
}

constexpr float PU_SCALE = 512.f, PV_SCALE = 32.f;
template <int NR> __device__ __forceinline__ void convert_rows_fp8(const float* src, unsigned char* dst, const float* scale, float scl, int lane) {
    f32x4 a[NR][8];
#pragma unroll
    for (int r = 0; r < NR; ++r)
#pragma unroll
        for (int j = 0; j < 2; ++j)
#pragma unroll
            for (int q = 0; q < 4; ++q) a[r][j * 4 + q] = *(const f32x4*)(src + (size_t)r * DM + j * 1024 + lane * 16 + 4 * q);
    f32x4 sc[8];
#pragma unroll
    for (int j = 0; j < 2; ++j)
#pragma unroll
        for (int q = 0; q < 4; ++q) sc[j * 4 + q] = scale ? *(const f32x4*)(scale + j * 1024 + lane * 16 + 4 * q) * scl : (f32x4){scl, scl, scl, scl};
#pragma unroll
    for (int r = 0; r < NR; ++r)
#pragma unroll
        for (int j = 0; j < 2; ++j) { u32x4 w;
#pragma unroll
            for (int q = 0; q < 4; ++q) { const f32x4 v = a[r][j * 4 + q] * sc[j * 4 + q]; unsigned p = 0; p = __builtin_amdgcn_cvt_pk_fp8_f32(v[0], v[1], p, false); p = __builtin_amdgcn_cvt_pk_fp8_f32(v[2], v[3], p, true); w[q] = p; }
            *(u32x4*)(dst + (size_t)r * DM + j * 1024 + lane * 16) = w; }
}
struct TrJob { const float* W; const float* scale; bf16_t* WT; int ldw, c0, ncols, r0, ldt, koff, map, item; };
__device__ __forceinline__ int colmap_rt(int map, int n) {
    if (map == 1) { const int h = n / 192, o = n % 192; if (o < 128) return n; const int j = o - 128; return h * 192 + 128 + (j >> 1) + 32 * (j & 1); }
    if (map == 2) return (n >> 1) + 32 * (n & 1);
    return n;
}
__device__ __forceinline__ void tr_load(const TrJob& J, int lane, float (&v)[32]) {
    const int nblk = J.ncols / 32, kb = J.item / nblk, nb = J.item % nblk, k0 = 64 * kb, n0 = 32 * nb;
    const int sc = J.c0 + colmap_rt(J.map, n0 + (lane & 31));
    const float* p = J.W + (size_t)(k0 + (lane >> 5)) * J.ldw + sc;
#pragma unroll
    for (int i = 0; i < 32; ++i) v[i] = p[(size_t)(2 * i) * J.ldw];
}
__device__ __forceinline__ void tr_store(const TrJob& J, int lane, LAS float* scr, const float (&v)[32]) {
    const int nblk = J.ncols / 32, kb = J.item / nblk, nb = J.item % nblk, k0 = 64 * kb, n0 = 32 * nb;
#pragma unroll
    for (int i = 0; i < 32; ++i) { const int kk = 2 * i + (lane >> 5); scr[kk * 33 + (lane & 31)] = J.scale ? v[i] * J.scale[k0 + kk] : v[i]; }
    asm volatile("s_waitcnt lgkmcnt(0)" ::: "memory");
    const int c = lane & 7;
#pragma unroll
    for (int j = 0; j < 4; ++j) { const int n = (lane >> 3) + 8 * j; const LAS float* s_ = scr + (8 * c) * 33 + n;
        u32x4 o; o.x = cvt_pk_bf16(s_[0 * 33], s_[1 * 33]); o.y = cvt_pk_bf16(s_[2 * 33], s_[3 * 33]); o.z = cvt_pk_bf16(s_[4 * 33], s_[5 * 33]); o.w = cvt_pk_bf16(s_[6 * 33], s_[7 * 33]);
        *(u32x4*)(J.WT + (size_t)(J.r0 + n0 + n) * J.ldt + J.koff + k0 + 8 * c) = o; }
    asm volatile("s_waitcnt lgkmcnt(0)" ::: "memory");
}

struct Args {
    const float* in[25]; float* out; unsigned char* ws; int ph_lo, ph_hi, layer, pad;
};
constexpr int TR_I1 = 0  , TR_I2 = 0  , TR_I3 = 32 * 2, TR_I4 = 8 * 48, TR_I5 = 8 * 64, TR_I6 = 16 * 64, TR_I9 = 32 * 64, TR_I10 = 0  ;
constexpr int TR_NIT = TR_I1 + TR_I2 + TR_I3 + TR_I4 + TR_I5 + 3 * TR_I6 + TR_I9 + TR_I10;
__device__ __forceinline__ TrJob tr_job(const Args& a, int l, unsigned char* wl, int it) {
    bf16_t* WA = (bf16_t*)(wl + WO_WA); const float* n1g = a.in[1] + l * DM;
    int r = it;
    if (r < TR_I1) return TrJob{a.in[2] + (size_t)l * DM * INC, n1g, WA, INC, 0, 6144, 0, DM, 0, 0, r}; r -= TR_I1;
    if (r < TR_I2) return TrJob{a.in[15] + (size_t)l * DM * 6144, n1g, WA, 6144, 0, 6144, 6144, DM, 0, 0, r}; r -= TR_I2;
    if (r < TR_I3) return TrJob{a.in[2] + (size_t)l * DM * INC, n1g, WA, INC, 6144, 64, 12288, DM, 0, 2, r}; r -= TR_I3;
    if (r < TR_I4) return TrJob{a.in[10] + (size_t)l * 512 * 1536, a.in[8] + l * 512, (bf16_t*)(wl + WO_WUQ), 1536, 0, 1536, 0, 512, 0, 1, r}; r -= TR_I4;
    if (r < TR_I5) return TrJob{a.in[11] + (size_t)l * 512 * 2048, a.in[9] + l * 512, (bf16_t*)(wl + WO_WUKV), 2048, 0, 2048, 0, 512, 0, 0, r}; r -= TR_I5;
    if (r < 3 * TR_I6) { const int br = r / TR_I6; return TrJob{(br == 0 ? a.in[12] : (br == 1 ? a.in[13] : a.in[14])) + (size_t)l * 1024 * DM, nullptr, (bf16_t*)(wl + WO_WBR), DM, 0, DM, 0, 3072, br * 1024, 0, r % TR_I6}; } r -= 3 * TR_I6;
    if (r < TR_I9) return TrJob{a.in[17] + (size_t)l * DM * DM, nullptr, (bf16_t*)(wl + WO_WOUT), DM, 0, DM, 0, DM, 0, 0, r}; r -= TR_I9;
    return TrJob{a.in[19] + (size_t)l * DM * DM, a.in[18] + l * DM, (bf16_t*)(wl + WO_WQ), DM, 0, DM, 0, DM, 0, 0, r};
}
constexpr int LDS_BYTES = 147456;
constexpr int CW_BAR = 4096;
constexpr int NWAVES = 8;

__device__ __forceinline__ void p0_prologue(const Args& a, LAS unsigned char* lds, int gw, int NGW, int wave, int lane) {
    LAS float* scr = (LAS float*)(lds + wave * 16384);
    unsigned char* ws = a.ws;
    for (int l = 0; l < DEPTH; ++l) {
        unsigned char* wl = ws + WS_W + (size_t)l * WL_STRIDE;
        bf16_t* WA = (bf16_t*)(wl + WO_WA); bf16_t* WUQ = (bf16_t*)(wl + WO_WUQ); bf16_t* WUKV = (bf16_t*)(wl + WO_WUKV); bf16_t* WBR = (bf16_t*)(wl + WO_WBR);
        bf16_t* WOUT = (bf16_t*)(wl + WO_WOUT); bf16_t* WQ = (bf16_t*)(wl + WO_WQ);
        const float* n1g = a.in[1] + l * DM; const float* n2g = a.in[18] + l * DM;
        const float* w_in = a.in[2] + (size_t)l * DM * INC; const float* w_gate = a.in[15] + (size_t)l * DM * 6144;
        {
            constexpr int NIT = TR_NIT; TrJob JA{}, JB{}; float vA[32], vB[32]; int it = gw;
            if (it < NIT) { JA = tr_job(a, l, wl, it); tr_load(JA, lane, vA); }
            while (it < NIT) {
                int nx = it + NGW;
                if (nx < NIT) { JB = tr_job(a, l, wl, nx); tr_load(JB, lane, vB); }
                tr_store(JA, lane, scr, vA);
                it = nx; if (it >= NIT) break;
                nx = it + NGW;
                if (nx < NIT) { JA = tr_job(a, l, wl, nx); tr_load(JA, lane, vA); }
                tr_store(JB, lane, scr, vB);
                it = nx;
            }
        }
        for (int it = gw; it < 192; it += NGW) { u32x4 z = {0u, 0u, 0u, 0u};
#pragma unroll
            for (int j = 0; j < 4; ++j) *(u32x4*)(WA + (size_t)(12352 + it) * DM + (j * 64 + lane) * 8) = z; }
        bf16_t* KLO = (bf16_t*)(wl + WO_KLO); bf16_t* KEYS = (bf16_t*)(wl + WO_KEYS); bf16_t* SGUW = (bf16_t*)(wl + WO_SGUW); bf16_t* PU = (bf16_t*)(wl + WO_PU); bf16_t* PV = (bf16_t*)(wl + WO_PV);
        constexpr int C1 = 64, C3 = 64, NCV = 2 * C1 + C3;
        for (int it = gw; it < NCV; it += NGW) {
            int r = it;
            if (r < C1) { convert_item_hilo(a.in[20] + (size_t)l * 131072 + (size_t)r * 2048, KEYS + (size_t)r * 2048, KLO + (size_t)r * 2048, lane); continue; } r -= C1;
            if (r < C1) { convert_item_hilo(a.in[21] + (size_t)l * 131072 + (size_t)r * 2048, KEYS + 131072 + (size_t)r * 2048, KLO + 131072 + (size_t)r * 2048, lane); continue; } r -= C1;
            convert_item(a.in[6] + (size_t)l * 131072 + (size_t)r * 2048, SGUW + (size_t)r * 2048, nullptr, lane);
        }
        for (int b4 = gw; b4 < NEXP / 2; b4 += NGW) convert_rows_fp8<2>(a.in[22] + ((size_t)l * NEXP + 2 * b4) * DM, (unsigned char*)PU + (size_t)(2 * b4) * DM, n2g, PU_SCALE, lane);
        for (int b4 = gw; b4 < NEXP / 2; b4 += NGW) convert_rows_fp8<2>(a.in[23] + ((size_t)l * NEXP + 2 * b4) * DM, (unsigned char*)PV + (size_t)(2 * b4) * DM, nullptr, PV_SCALE, lane);
    }
    f32x2* rope = (f32x2*)(ws + WS_ROPE);
    for (int it = gw; it < SEQ * 32 / 64; it += NGW) { const int e = it * 64 + lane, s = e >> 5, i = e & 31;
        const float inv = exp2f(-(float)i * (13.287712379549449f / 32.f)); const float ang = (float)s * inv; float sn, cs; sincosf(ang, &sn, &cs); rope[e] = (f32x2){cs, sn}; }
    const float* x = a.in[0]; bf16_t* XB = (bf16_t*)(ws + WS_XB); float* RS = (float*)(ws + WS_RS); unsigned char* XQ = ws + WS_XQ; float* SA = (float*)(ws + WS_SA);
    for (int t = gw; t < T; t += NGW) { float s = 0.f, am = 0.f; f32x4 pv[4], qv[4];
#pragma unroll
        for (int j = 0; j < 4; ++j) { const int e = (j * 64 + lane) * 8; const f32x4 p = *(const f32x4*)(x + (size_t)t * DM + e), q = *(const f32x4*)(x + (size_t)t * DM + e + 4); pv[j] = p; qv[j] = q;
            s += (p[0] * p[0] + p[1] * p[1]) + (p[2] * p[2] + p[3] * p[3]) + (q[0] * q[0] + q[1] * q[1]) + (q[2] * q[2] + q[3] * q[3]); store8_bf16(XB + (size_t)t * DM + e, p, q);
#pragma unroll
            for (int i = 0; i < 4; ++i) am = fmaxf(am, fmaxf(fabsf(p[i]), fabsf(q[i]))); }
        s = wave_sum(s);
#pragma unroll
        for (int o = 1; o < 64; o <<= 1) am = fmaxf(am, __shfl_xor(am, o));
        const float inv = am > 0.f ? 127.f / am : 0.f;
#pragma unroll
        for (int j = 0; j < 4; ++j) { const int e = (j * 64 + lane) * 8; u32x2 w; w.x = pack4_q8(pv[j][0] * inv, pv[j][1] * inv, pv[j][2] * inv, pv[j][3] * inv); w.y = pack4_q8(qv[j][0] * inv, qv[j][1] * inv, qv[j][2] * inv, qv[j][3] * inv);
            *(u32x2*)(XQ + (size_t)t * DM + e) = w; }
        if (lane == 0) { RS[t] = rsqrtf(s * (1.f / DM) + EPS); SA[t] = am * (1.f / 127.f); } }
}
__device__ __forceinline__ void p0_key_fold(const Args& a, int gw, int NGW, int lane) {
    const int n = lane & 15, g = lane >> 4;
    for (int task = gw; task < DEPTH * 16 * 64; task += NGW) {
        const int l = task >> 10, blk = (task >> 6) & 15, h = blk >> 1, side = blk & 1, kq = task & 63;
        unsigned char* wl = a.ws + WS_W + (size_t)l * WL_STRIDE;
        const float* KF32 = (side ? a.in[21] : a.in[20]) + (size_t)l * 131072 + (size_t)h * 128 * 128 + 8 * g;
        bf16_t* WQT = (bf16_t*)(wl + WO_WQ) + (size_t)(h * 256 + side * 128) * DM + kq * 32 + n;
        const float* wq = a.in[19] + (size_t)l * DM * DM + (size_t)(kq * 32 + n) * DM + h * 256 + side * 128 + 8 * g; const float* g2 = a.in[18] + l * DM + kq * 32 + n;
        bf16x8 bq[2][4];
#pragma unroll
        for (int kg = 0; kg < 2; ++kg) { const float sc = g2[16 * kg]; const float* rp = wq + (size_t)(16 * kg) * DM;
#pragma unroll
            for (int ks = 0; ks < 4; ++ks) { const f32x4 p = *(const f32x4*)(rp + 32 * ks) * sc, q = *(const f32x4*)(rp + 32 * ks + 4) * sc;
                u32x4 w; w.x = cvt_pk_bf16(p[0], p[1]); w.y = cvt_pk_bf16(p[2], p[3]); w.z = cvt_pk_bf16(q[0], q[1]); w.w = cvt_pk_bf16(q[2], q[3]); bq[kg][ks] = __builtin_bit_cast(bf16x8, w); } }
#pragma unroll 1
        for (int kt = 0; kt < 8; ++kt) {
            bf16x8 ah[4], al[4];
#pragma unroll
            for (int ks = 0; ks < 4; ++ks) { const float* kp = KF32 + (size_t)(16 * kt + n) * 128 + 32 * ks; const f32x4 p = *(const f32x4*)kp, q = *(const f32x4*)(kp + 4);
                u32x4 hw; hw.x = cvt_pk_bf16(p[0], p[1]); hw.y = cvt_pk_bf16(p[2], p[3]); hw.z = cvt_pk_bf16(q[0], q[1]); hw.w = cvt_pk_bf16(q[2], q[3]);
                u32x4 lw; lw.x = cvt_pk_bf16(p[0] - bf2f(hw.x & 0xffffu), p[1] - bf2f(hw.x >> 16)); lw.y = cvt_pk_bf16(p[2] - bf2f(hw.y & 0xffffu), p[3] - bf2f(hw.y >> 16));
                lw.z = cvt_pk_bf16(q[0] - bf2f(hw.z & 0xffffu), q[1] - bf2f(hw.z >> 16)); lw.w = cvt_pk_bf16(q[2] - bf2f(hw.w & 0xffffu), q[3] - bf2f(hw.w >> 16));
                ah[ks] = __builtin_bit_cast(bf16x8, hw); al[ks] = __builtin_bit_cast(bf16x8, lw); }
#pragma unroll
            for (int kg = 0; kg < 2; ++kg) { f32x4 acc = {0.f, 0.f, 0.f, 0.f};
#pragma unroll
                for (int ks = 0; ks < 4; ++ks) { acc = __builtin_amdgcn_mfma_f32_16x16x32_bf16(ah[ks], bq[kg][ks], acc, 0, 0, 0); acc = __builtin_amdgcn_mfma_f32_16x16x32_bf16(al[ks], bq[kg][ks], acc, 0, 0, 0); }
#pragma unroll
                for (int r = 0; r < 4; ++r) WQT[(size_t)(16 * kt + 4 * g + r) * DM + 16 * kg] = (bf16_t)f2bf(acc[r]); }
        }
    }
}
__device__ __forceinline__ void p0_quant_strips(const Args& a, LAS unsigned char* lds, const int tid, const int G, const int bx) {
    const int lane = tid & 63, wave = __builtin_amdgcn_readfirstlane(tid >> 6), r = lane >> 3, cg = lane & 7;
    unsigned char* ws = a.ws;
    LAS unsigned char* SB_ = lds;
    LAS float* WMAX = (LAS float*)(lds + 131072);
    for (int strip = bx; strip < DEPTH * 2 * 192; strip += G) {
        const int l = strip / 384, wh = (strip / 192) & 1, nb = strip % 192, n0 = 32 * nb, ld = wh ? 6144 : INC, ng = wh * 6144 + n0;
        const float* W = (wh ? a.in[15] + (size_t)l * DM * 6144 : a.in[2] + (size_t)l * DM * INC) + n0 + 4 * cg; const float* g1 = a.in[1] + l * DM;
        f32x4 m = {0.f, 0.f, 0.f, 0.f};
        f32x4 wa[8], wb[8]; float ga[8], gb[8];
#define QS_LOAD(WR, GN, KB) do { const int k0_ = 64 * (KB); _Pragma("unroll") for (int i = 0; i < 8; ++i) { WR[i] = *(const f32x4*)(W + (size_t)(k0_ + 8 * i + r) * ld); GN[i] = g1[k0_ + 8 * i + r]; } } while (0)
#define QS_STASH(WR, GN, KB) do { const int k0_ = 64 * (KB); _Pragma("unroll") for (int i = 0; i < 8; ++i) { const f32x4 v = WR[i] * GN[i]; const int k_ = k0_ + 8 * i + r; \
            m[0] = fmaxf(m[0], fabsf(v[0])); m[1] = fmaxf(m[1], fabsf(v[1])); m[2] = fmaxf(m[2], fabsf(v[2])); m[3] = fmaxf(m[3], fabsf(v[3])); \
            *(LAS u32x2*)(SB_ + k_ * 64 + ((cg ^ (k_ & 7)) * 8)) = (u32x2){cvt_pk_bf16(v[0], v[1]), cvt_pk_bf16(v[2], v[3])}; } } while (0)
        QS_LOAD(wa, ga, wave); QS_LOAD(wb, gb, wave + 8);
        QS_STASH(wa, ga, wave); QS_LOAD(wa, ga, wave + 16);
        QS_STASH(wb, gb, wave + 8); QS_LOAD(wb, gb, wave + 24);
        QS_STASH(wa, ga, wave + 16);
        QS_STASH(wb, gb, wave + 24);
#undef QS_LOAD
#undef QS_STASH
#pragma unroll
        for (int i = 0; i < 4; ++i) { float v = m[i]; v = fmaxf(v, __shfl_xor(v, 8)); v = fmaxf(v, __shfl_xor(v, 16)); v = fmaxf(v, __shfl_xor(v, 32)); m[i] = v; }
        if (r == 0) *(LAS f32x4*)(WMAX + wave * 32 + 4 * cg) = m;
        __syncthreads();
        const int c = lane & 3;
#pragma unroll
        for (int hf = 0; hf < 2; ++hf) { const int n = (lane >> 2) + 16 * hf; float cmax = WMAX[n];
#pragma unroll
            for (int w_ = 1; w_ < 8; ++w_) cmax = fmaxf(cmax, WMAX[w_ * 32 + n]);
            const float inv = cmax > 0.f ? 127.f / cmax : 0.f; const int cgn = n >> 2, sub = (n & 3) * 2;
#pragma unroll
            for (int kq = 0; kq < 4; ++kq) { const int kb = wave + 8 * kq, kbase = 64 * kb + 16 * c; u32x4 o;
#pragma unroll
                for (int q = 0; q < 4; ++q) { float f[4];
#pragma unroll
                    for (int e = 0; e < 4; ++e) { const int k_ = kbase + 4 * q + e; f[e] = bf2f((unsigned)*(const LAS unsigned short*)(SB_ + k_ * 64 + ((cgn ^ (k_ & 7)) * 8) + sub)) * inv; }
                    o[q] = pack4_q8(f[0], f[1], f[2], f[3]); }
                *(u32x4*)(ws + WS_WGQ + (size_t)l * 12288 * DM + (size_t)(ng + n) * DM + kbase) = o; }
            if (wave == 0 && c == 0) ((float*)(ws + WS_SB))[l * 12288 + ng + n] = cmax * (1.f / 127.f); }
        __syncthreads();
    }
}
__device__ __forceinline__ void p0_gates_quant(const Args& a, LAS unsigned char* lds, int gw, int NGW, int wave, int lane) {
    LAS float* scr = (LAS float*)(lds + wave * 16384); unsigned char* ws = a.ws;
    constexpr int NIT = DEPTH * 2 * 32 * 192;
    auto mkjob = [](const Args& a_, int it) { const int l = it / (2 * 32 * 192), wh = (it / (32 * 192)) & 1; return TrJob{wh ? a_.in[15] + (size_t)l * DM * 6144 : a_.in[2] + (size_t)l * DM * INC, a_.in[1] + l * DM, nullptr, wh ? 6144 : INC, 0, 6144, l  , DM, wh * 6144  , 0, it % (32 * 192)}; };
    auto qload = [&](const TrJob& J, f32x4 (&w)[8], float (&gn)[8]) {
        const int nblk = J.ncols / 32, kb = J.item / nblk, nb = J.item % nblk, k0 = 64 * kb, n0 = 32 * nb;
        const float* p = J.W + (size_t)(k0 + (lane >> 3)) * J.ldw + n0 + 4 * (lane & 7);
#pragma unroll
        for (int i = 0; i < 8; ++i) { w[i] = *(const f32x4*)(p + (size_t)(8 * i) * J.ldw); gn[i] = J.scale[k0 + 8 * i + (lane >> 3)]; }
    };
    auto store = [&](const TrJob& J, const f32x4 (&w)[8], const float (&gn)[8]) {
        const int nblk = J.ncols / 32, kb = J.item / nblk, nb = J.item % nblk, k0 = 64 * kb, n0 = 32 * nb, l = J.r0, ng = J.koff + n0;
#pragma unroll
        for (int i = 0; i < 8; ++i) { LAS float* sp_ = scr + (8 * i + (lane >> 3)) * 33 + 4 * (lane & 7); const f32x4 v = w[i] * gn[i]; sp_[0] = v[0]; sp_[1] = v[1]; sp_[2] = v[2]; sp_[3] = v[3]; }
        asm volatile("s_waitcnt lgkmcnt(0)" ::: "memory");
        const int c = lane & 3;
#pragma unroll
        for (int hf = 0; hf < 2; ++hf) { const int n = (lane >> 2) + 16 * hf;
            const float cmax = __uint_as_float(__hip_atomic_load((const unsigned*)(ws + WS_CTL + CTL_CMAX) + l * 12288 + ng + n, __ATOMIC_RELAXED, __HIP_MEMORY_SCOPE_AGENT)); const float inv = cmax > 0.f ? 127.f / cmax : 0.f;
            const LAS float* s_ = scr + (16 * c) * 33 + n; u32x4 o;
#pragma unroll
            for (int q = 0; q < 4; ++q) o[q] = pack4_q8(s_[(4 * q) * 33] * inv, s_[(4 * q + 1) * 33] * inv, s_[(4 * q + 2) * 33] * inv, s_[(4 * q + 3) * 33] * inv);
            *(u32x4*)(ws + WS_WGQ + (size_t)l * 12288 * DM + (size_t)(ng + n) * DM + k0 + 16 * c) = o;
            if (kb == 0 && c == 0) ((float*)(ws + WS_SB))[l * 12288 + ng + n] = cmax * (1.f / 127.f); }
        asm volatile("s_waitcnt lgkmcnt(0)" ::: "memory");
    };
    TrJob JA{}, JB{}; f32x4 wA[8], wB[8]; float gA[8], gB[8]; int it = gw;
    if (it < NIT) { JA = mkjob(a, it); qload(JA, wA, gA); }
    while (it < NIT) {
        int nx = it + NGW;
        if (nx < NIT) { JB = mkjob(a, nx); qload(JB, wB, gB); }
        store(JA, wA, gA);
        it = nx; if (it >= NIT) break;
        nx = it + NGW;
        if (nx < NIT) { JA = mkjob(a, nx); qload(JA, wA, gA); }
        store(JB, wB, gB);
        it = nx;
    }
}

enum Phase { PH_P0 = 0, PH_A = 1, PH_B = 2, PH_C = 3, PH_D = 4, PH_E = 5, PH_F = 6, PH_G1 = 7, PH_G2 = 8, PH_N = 9 };
namespace mla {
using s16x4 = __attribute__((ext_vector_type(4))) short;
using f32x16 = __attribute__((ext_vector_type(16))) float;
constexpr int DQ = 192, DV = 128, QBLK = 32, KVBLK = 64, LDQ = 1536, LDK = 1536, LDV = 1024, LDO = 3072;
constexpr int SHM_V = KVBLK * DV * 2, SHM_K = KVBLK * DQ * 2, SHM_ATTN = 2 * SHM_V + 2 * SHM_K + 8 * 64 * 4;
constexpr float THR = 8.f;
#define MKSWZ(row, colB) ((row) * 384 + ((colB) ^ (((row) & 7) << 4)))
#define MSBAR() __builtin_amdgcn_sched_barrier(0)
__device__ __forceinline__ int crow(int r, int hi) { return (r & 3) + 8 * (r >> 2) + 4 * hi; }
__device__ __forceinline__ void partialSM(f32x16& p0, f32x16& p1, float& m_reg, float& mn, float& alpha) {
  constexpr float C = MLA_SCALE * 1.4426950408889634f;
  float pmax = p0[0];
#pragma unroll
  for (int r = 1; r < 16; ++r) pmax = fmaxf(pmax, p0[r]);
#pragma unroll
  for (int r = 0; r < 16; ++r) pmax = fmaxf(pmax, p1[r]);
  { auto rr = __builtin_amdgcn_permlane32_swap(__float_as_uint(pmax), __float_as_uint(pmax), false, false); pmax = fmaxf(__uint_as_float(rr[0]), __uint_as_float(rr[1])); }
  if (__builtin_expect(__all(pmax - m_reg <= THR / MLA_SCALE), 1)) { mn = m_reg; alpha = 1.f; }
  else { mn = fmaxf(m_reg, pmax); alpha = __builtin_amdgcn_exp2f((m_reg - mn) * C); m_reg = mn; }
  const float mnC = -mn * C;
#pragma unroll
  for (int r = 0; r < 16; ++r) p0[r] = fmaf(p0[r], C, mnC);
#pragma unroll
  for (int r = 0; r < 16; ++r) p1[r] = fmaf(p1[r], C, mnC);
#pragma unroll
  for (int r = 0; r < 16; ++r) p0[r] = __builtin_amdgcn_exp2f(p0[r]);
}
__device__ __forceinline__ void finishSM(f32x16& p0, f32x16& p1, float alpha, float& l_reg, bf16x8& pa0, bf16x8& pa1, bf16x8& pa2, bf16x8& pa3) {
#pragma unroll
  for (int r = 0; r < 16; ++r) p1[r] = __builtin_amdgcn_exp2f(p1[r]);
  float ps = 0;
#pragma unroll
  for (int r = 0; r < 16; ++r) ps += p0[r];
#pragma unroll
  for (int r = 0; r < 16; ++r) ps += p1[r];
  { auto rr = __builtin_amdgcn_permlane32_swap(__float_as_uint(ps), __float_as_uint(ps), false, false); ps = __uint_as_float(rr[0]) + __uint_as_float(rr[1]); }
  l_reg = l_reg * alpha + ps;
#define MPK4(P, BASE, OUT) do { unsigned a0 = cvt_pk_bf16(P[BASE + 0], P[BASE + 1]), a1 = cvt_pk_bf16(P[BASE + 2], P[BASE + 3]);   \
    unsigned b0 = cvt_pk_bf16(P[BASE + 4], P[BASE + 5]), b1 = cvt_pk_bf16(P[BASE + 6], P[BASE + 7]);                              \
    auto r0 = __builtin_amdgcn_permlane32_swap(a0, b0, false, false); auto r1 = __builtin_amdgcn_permlane32_swap(a1, b1, false, false); \
    u32x4 w = {r0[0], r1[0], r0[1], r1[1]}; OUT = __builtin_bit_cast(bf16x8, w); } while (0)
  MPK4(p0, 0, pa0); MPK4(p0, 8, pa1); MPK4(p1, 0, pa2); MPK4(p1, 8, pa3);
#undef MPK4
}
__device__ __forceinline__ void qkt(f32x16& p0, f32x16& p1, const LAS unsigned char* Ks, const bf16x8* qr, int r32, int hi) {
  p0 = f32x16{}; p1 = f32x16{};
#pragma unroll
  for (int d0 = 0; d0 < 12; ++d0) { const int cb = (d0 * 16 + hi * 8) * 2;
    const bf16x8 b0 = *(const LAS bf16x8*)(Ks + MKSWZ(r32, cb));
    const bf16x8 b1 = *(const LAS bf16x8*)(Ks + MKSWZ(32 + r32, cb));
    p0 = __builtin_amdgcn_mfma_f32_32x32x16_bf16(b0, qr[d0], p0, 0, 0, 0);
    p1 = __builtin_amdgcn_mfma_f32_32x32x16_bf16(b1, qr[d0], p1, 0, 0, 0); }
}
__device__ __forceinline__ int v_st(int k, int c) { const int kk = (k & ~0xC) | ((k & 4) << 1) | ((k & 8) >> 1); return ((kk >> 3) * 4 + (c >> 5)) * 512 + ((kk & 7) * 32 + (c & 31)) * 2; }
__device__ __forceinline__ int v_rd_base(int lane) { return ((lane & 3) << 3) | (((lane >> 2) & 3) << 6) | (((lane >> 4) & 1) << 5) | (((lane >> 5) & 1) << 8); }
constexpr int v_rd_off(int d0, int ks, int half) { return d0 * 512 + ks * 4096 + half * 2048; }
template <int OFF> __device__ __forceinline__ s16x4 tr_read(int vb) { s16x4 r; asm volatile("ds_read_b64_tr_b16 %0, %1 offset:%2" : "=&v"(r) : "v"(vb), "i"(OFF) : "memory"); return r; }
template <int D0> __device__ __forceinline__ void pv_one(f32x16& od, int vb, bf16x8 pa0, bf16x8 pa1, bf16x8 pa2, bf16x8 pa3) {
  const s16x4 l0 = tr_read<v_rd_off(D0, 0, 0)>(vb), h0 = tr_read<v_rd_off(D0, 0, 1)>(vb), l1 = tr_read<v_rd_off(D0, 1, 0)>(vb), h1 = tr_read<v_rd_off(D0, 1, 1)>(vb);
  const s16x4 l2 = tr_read<v_rd_off(D0, 2, 0)>(vb), h2 = tr_read<v_rd_off(D0, 2, 1)>(vb), l3 = tr_read<v_rd_off(D0, 3, 0)>(vb), h3 = tr_read<v_rd_off(D0, 3, 1)>(vb);
  asm volatile("s_waitcnt lgkmcnt(0)" ::: "memory"); MSBAR();
#define MPK(L, H) (bf16x8){L[0], L[1], L[2], L[3], H[0], H[1], H[2], H[3]}
  od = __builtin_amdgcn_mfma_f32_32x32x16_bf16(pa0, MPK(l0, h0), od, 0, 0, 0);
  od = __builtin_amdgcn_mfma_f32_32x32x16_bf16(pa1, MPK(l1, h1), od, 0, 0, 0);
  od = __builtin_amdgcn_mfma_f32_32x32x16_bf16(pa2, MPK(l2, h2), od, 0, 0, 0);
  od = __builtin_amdgcn_mfma_f32_32x32x16_bf16(pa3, MPK(l3, h3), od, 0, 0, 0);
#undef MPK
}
__device__ __forceinline__ void pv_d0(f32x16* o, int vb, bf16x8 pa0, bf16x8 pa1, bf16x8 pa2, bf16x8 pa3) {
  pv_one<0>(o[0], vb, pa0, pa1, pa2, pa3); pv_one<1>(o[1], vb, pa0, pa1, pa2, pa3); pv_one<2>(o[2], vb, pa0, pa1, pa2, pa3); pv_one<3>(o[3], vb, pa0, pa1, pa2, pa3);
}
__device__ __forceinline__ void attn_unit(const int tid, const bf16_t* __restrict__ Qb, const bf16_t* __restrict__ Kh, const bf16_t* __restrict__ Vh, bf16_t* __restrict__ Ob, int seq, LAS unsigned char* lds) {
  const int wid = __builtin_amdgcn_readfirstlane(tid >> 6), lane = tid & 63, r32 = lane & 31, hi = lane >> 5;
  LAS unsigned char* V_lds = lds; LAS unsigned char* K_lds = lds + 2 * SHM_V;
  LAS float* ws = (LAS float*)(lds + 2 * SHM_V + 2 * SHM_K) + wid * 64; LAS float* li_l = ws; LAS float* al_l = ws + 32;
  float m_reg = -1e30f, l_reg = 0; f32x16 o[4] = {}; bf16x8 qr[12];
  const bf16_t* Qw = Qb + (size_t)(wid * QBLK + r32) * LDQ + hi * 8;
#pragma unroll
  for (int d0 = 0; d0 < 12; ++d0) qr[d0] = *(const bf16x8*)(Qw + d0 * 16);
  const bf16_t* ksrc[3]; const bf16_t* vsrc[2];
#pragma unroll
  for (int i = 0; i < 3; ++i) { const int p = tid + 512 * i, row = p / 24, d = p % 24; ksrc[i] = Kh + (size_t)row * LDK + ((d ^ (row & 7)) * 8); }
#pragma unroll
  for (int i = 0; i < 2; ++i) { const int p = tid + 512 * i, sub = p >> 5, kk = (sub >> 2) * 8 + ((p & 31) >> 2), c = (sub & 3) * 32 + (p & 3) * 8, k = (kk & ~0xC) | ((kk & 4) << 1) | ((kk & 8) >> 1);
    vsrc[i] = Vh + (size_t)k * LDV + c; }
  const int vb0 = (int)(unsigned)(uintptr_t)V_lds + v_rd_base(lane);
#define MDMA(t, b) do { _Pragma("unroll") for (int i_ = 0; i_ < 3; ++i_) __builtin_amdgcn_global_load_lds((const unsigned*)(ksrc[i_] + (size_t)(t) * KVBLK * LDK), (LAS unsigned*)(K_lds + (b) * SHM_K + (i_ * 8 + wid) * 1024), 16, 0, 0); \
    _Pragma("unroll") for (int i_ = 0; i_ < 2; ++i_) __builtin_amdgcn_global_load_lds((const unsigned*)(vsrc[i_] + (size_t)(t) * KVBLK * LDV), (LAS unsigned*)(V_lds + (b) * SHM_V + (i_ * 8 + wid) * 1024), 16, 0, 0); } while (0)
#define MSWAIT() asm volatile("s_waitcnt vmcnt(0)" ::: "memory")
#define MRESC(a) do { if (__any((a) < 1.f)) { if (hi == 0) al_l[r32] = (a); asm volatile("s_waitcnt lgkmcnt(0)" ::: "memory"); \
    _Pragma("unroll") for (int d = 0; d < 4; ++d) _Pragma("unroll") for (int r = 0; r < 16; ++r) o[d][r] *= al_l[crow(r, hi)]; } } while (0)
  f32x16 p0, p1; float mn, al; bf16x8 pa0, pa1, pa2, pa3; const int NT = seq / KVBLK;
  MDMA(0, 0); MSWAIT(); __syncthreads();
  for (int j = 0; j < NT; ++j) {
    const int buf = j & 1;
    if (j + 1 < NT) MDMA(j + 1, buf ^ 1);
    MSBAR(); qkt(p0, p1, K_lds + buf * SHM_K, qr, r32, hi);
    partialSM(p0, p1, m_reg, mn, al);
    MRESC(al);
    finishSM(p0, p1, al, l_reg, pa0, pa1, pa2, pa3); MSBAR();
    pv_d0(o, vb0 + buf * SHM_V, pa0, pa1, pa2, pa3);
    MSWAIT(); __syncthreads();
  }
  if (hi == 0) li_l[r32] = l_reg; asm volatile("s_waitcnt lgkmcnt(0)" ::: "memory");
  float rli[16];
#pragma unroll
  for (int r = 0; r < 16; ++r) rli[r] = __builtin_amdgcn_rcpf(li_l[crow(r, hi)]);
  bf16_t* Ow = Ob + (size_t)(wid * QBLK) * LDO;
#pragma unroll
  for (int r = 0; r < 16; ++r) { const int orow = crow(r, hi);
#pragma unroll
    for (int d0 = 0; d0 < 4; ++d0) Ow[(size_t)orow * LDO + d0 * 32 + r32] = (bf16_t)f2bf(o[d0][r] * rli[r]); }
  __syncthreads();
#undef MDMA
#undef MSWAIT
#undef MRESC
}
#undef MKSWZ
#undef MSBAR
}
__device__ __forceinline__ void mla_attn_phase(const int tid, unsigned char* ws, LAS unsigned char* lds, int G, int vcu) {
    const bf16_t* QF = (const bf16_t*)(ws + WS_QF); const bf16_t* KF = (const bf16_t*)(ws + WS_KF); const bf16_t* VF = (const bf16_t*)(ws + WS_VF); bf16_t* OCAT = (bf16_t*)(ws + WS_OCAT);
    for (int u = vcu; u < NBATCH * 8 * (SEQ / 256); u += G) { const int bh = u / (SEQ / 256), qb = u % (SEQ / 256), b = bh >> 3, h = bh & 7; const size_t r0 = (size_t)b * SEQ;
        mla::attn_unit(tid, QF + (r0 + qb * 256) * 1536 + h * 192, KF + r0 * 1536 + h * 192, VF + r0 * 1024 + h * 128, OCAT + (r0 + qb * 256) * 3072 + 2048 + h * 128, SEQ, lds); }
}


namespace na {
constexpr int VROW = 288, PROW = 528;
typedef short v4i16_t __attribute__((ext_vector_type(4)));
__device__ __forceinline__ int rho(int j) { return (j & ~0xC) | ((j & 4) << 1) | ((j & 8) >> 1); }
constexpr int L_V = 0, L_P = 256 * VROW, L_WM = L_P + 16 * PROW, L_WL = L_WM + 512, L_BIAS = L_WL + 512, L_END = L_BIAS + 8 * 15 * 31 * 4;
__device__ __forceinline__ void phase(const int tid, unsigned char* ws, const float* bias, LAS unsigned char* lds, int G, int vcu) {
    const bf16_t* QA = (const bf16_t*)(ws + WS_QA); const bf16_t* KA = (const bf16_t*)(ws + WS_KA); const bf16_t* VA = (const bf16_t*)(ws + WS_VA); bf16_t* OCAT = (bf16_t*)(ws + WS_OCAT);
    const int lane = tid & 63, w = __builtin_amdgcn_readfirstlane(tid >> 6), n = lane & 15, g = lane >> 4;
    LAS float* WM = (LAS float*)(lds + L_WM); LAS float* WL = (LAS float*)(lds + L_WL);
    constexpr int NITEM = NBATCH * 8 * 64 * 4; const int PER = (NITEM + G - 1) / G;
    u32x4 vreg[8]; bf16x8 kreg[8], qreg[4];
    LAS float* BL = (LAS float*)(lds + L_BIAS);
    for (int i = tid; i < 8 * 15 * 31; i += 512) BL[i] = bias[i];
    __syncthreads();
#define NA_DECODE(IT) const int cb_ = (IT) & 3, r_ = ((IT) >> 2) & 63, h_ = ((IT) >> 8) & 7, b_ = (IT) >> 11, c0_ = cb_ * 16; \
        int rs_ = r_ - 4; rs_ = rs_ < 0 ? 0 : (rs_ > 56 ? 56 : rs_); int st_ = c0_ - 8; st_ = st_ < 0 ? 0 : (st_ > 32 ? 32 : st_); const size_t tb_ = (size_t)b_ * SEQ
#define NA_FETCH(IT) do { NA_DECODE(IT); \
        _Pragma("unroll") for (int i = 0; i < 8; ++i) { const int id = tid + 512 * i, j = id >> 4, c16 = id & 15; const size_t tok = tb_ + (size_t)(rs_ + (j >> 5)) * GW_ + st_ + (j & 31); \
            vreg[i] = *(const u32x4*)(VA + tok * 1024 + h_ * 128 + c16 * 8); } \
        const size_t tq = tb_ + (size_t)r_ * GW_ + c0_ + n; const bf16_t* qp = QA + tq * 1024 + h_ * 128 + 8 * g; \
        const size_t tk0 = tb_ + (size_t)(rs_ + w) * GW_ + st_ + n; const bf16_t* kp0 = KA + tk0 * 1024 + h_ * 128 + 8 * g; \
        _Pragma("unroll") for (int ks = 0; ks < 4; ++ks) { qreg[ks] = *(const bf16x8*)(qp + 32 * ks); kreg[ks] = *(const bf16x8*)(kp0 + 32 * ks); kreg[4 + ks] = *(const bf16x8*)(kp0 + 16 * 1024 + 32 * ks); } } while (0)
    const int it_lo = vcu * PER, it_hi = (vcu + 1) * PER < NITEM ? (vcu + 1) * PER : NITEM;
    if (it_lo < it_hi) NA_FETCH(it_lo);
    for (int it = it_lo; it < it_hi; ++it) {
        const int cb = it & 3, r = (it >> 2) & 63, h = (it >> 8) & 7, b = it >> 11, c0 = cb * 16;
        int rs = r - 4; rs = rs < 0 ? 0 : (rs > 56 ? 56 : rs);
        int start = c0 - 8; start = start < 0 ? 0 : (start > 32 ? 32 : start);
        const size_t tb = (size_t)b * SEQ;
#pragma unroll
        for (int i = 0; i < 8; ++i) { const int id = tid + 512 * i, j = id >> 4, c16 = id & 15; *(LAS u32x4*)(lds + L_V + rho(j) * VROW + c16 * 16) = vreg[i]; }
        f32x4 acc[2] = {(f32x4){0.f, 0.f, 0.f, 0.f}, (f32x4){0.f, 0.f, 0.f, 0.f}};
#pragma unroll
        for (int ks = 0; ks < 4; ++ks) { acc[0] = __builtin_amdgcn_mfma_f32_16x16x32_bf16(kreg[ks], qreg[ks], acc[0], 0, 0, 0); acc[1] = __builtin_amdgcn_mfma_f32_16x16x32_bf16(kreg[4 + ks], qreg[ks], acc[1], 0, 0, 0); }
        asm volatile("" ::: "memory");
        if (it + 1 < it_hi) NA_FETCH(it + 1);
        const int c = c0 + n; int cs = c - 8; cs = cs < 0 ? 0 : (cs > 48 ? 48 : cs);
        const LAS float* brow = BL + (h * 15 + (rs + w - r + 7)) * 31;
        float sv[8]; float mx = -1e30f;
#pragma unroll
        for (int kt = 0; kt < 2; ++kt)
#pragma unroll
            for (int rg = 0; rg < 4; ++rg) { const int kc = start + 16 * kt + 4 * g + rg; const bool valid = kc >= cs && kc < cs + 16; int dc = kc - c + 15; dc = dc < 0 ? 0 : (dc > 30 ? 30 : dc);
                const float v = valid ? acc[kt][rg] + brow[dc] : -1e30f; sv[kt * 4 + rg] = v; mx = fmaxf(mx, v); }
        mx = fmaxf(mx, __shfl_xor(mx, 16)); mx = fmaxf(mx, __shfl_xor(mx, 32));
        if (g == 0) WM[w * 16 + n] = mx;
        __syncthreads();
        float M = WM[n];
#pragma unroll
        for (int ww = 1; ww < 8; ++ww) M = fmaxf(M, WM[ww * 16 + n]);
        float ls = 0.f;
#pragma unroll
        for (int i = 0; i < 8; ++i) { const float p = sv[i] > -1e29f ? __expf(sv[i] - M) : 0.f; sv[i] = p; ls += p; }
        ls += __shfl_xor(ls, 16); ls += __shfl_xor(ls, 32);
        if (g == 0) WL[w * 16 + n] = ls;
#pragma unroll
        for (int kt = 0; kt < 2; ++kt) { LAS u32x2* pp = (LAS u32x2*)(lds + L_P + n * PROW + (32 * w + 16 * kt + 4 * g) * 2);
            u32x2 pw; pw.x = cvt_pk_bf16(sv[kt * 4 + 0], sv[kt * 4 + 1]); pw.y = cvt_pk_bf16(sv[kt * 4 + 2], sv[kt * 4 + 3]); *pp = pw; }
        __syncthreads();
        f32x4 o = (f32x4){0.f, 0.f, 0.f, 0.f};
#pragma unroll
        for (int ks = 0; ks < 8; ++ks) { const bf16x8 pf = *(const LAS bf16x8*)(lds + L_P + n * PROW + (32 * ks + 8 * g) * 2);
            const int kp = 32 * ks + 8 * g + (n >> 2); const int dcol = (16 * w + 4 * (n & 3)) * 2;
            const v4i16_t t0 = __builtin_amdgcn_ds_read_tr16_b64_v4i16((LAS v4i16_t*)(lds + L_V + rho(kp) * VROW + dcol));
            const v4i16_t t1 = __builtin_amdgcn_ds_read_tr16_b64_v4i16((LAS v4i16_t*)(lds + L_V + rho(kp + 4) * VROW + dcol));
            const bf16x8 vf = (bf16x8){t0[0], t0[1], t0[2], t0[3], t1[0], t1[1], t1[2], t1[3]};
            o = __builtin_amdgcn_mfma_f32_16x16x32_bf16(pf, vf, o, 0, 0, 0); }
#pragma unroll
        for (int rg = 0; rg < 4; ++rg) { const int q = 4 * g + rg; float L = 0.f;
#pragma unroll
            for (int ww = 0; ww < 8; ++ww) L += WL[ww * 16 + q];
            OCAT[(tb + (size_t)r * GW_ + c0 + q) * 3072 + h * 128 + 16 * w + n] = (bf16_t)f2bf(o[rg] / L); }
        __syncthreads();
    }
#undef NA_FETCH
#undef NA_DECODE
}
}


namespace na3 {
constexpr int VP = 288, CHUNK = 32 * VP, L_BIAS = 8 * CHUNK;
typedef short v4i16_t __attribute__((ext_vector_type(4)));
__device__ __forceinline__ void phase(const int tid, unsigned char* ws, const float* bias, LAS unsigned char* lds, int G, int vcu) {
    const bf16_t* QA = (const bf16_t*)(ws + WS_QA); const bf16_t* KA = (const bf16_t*)(ws + WS_KA); const bf16_t* VA = (const bf16_t*)(ws + WS_VA); bf16_t* OCAT = (bf16_t*)(ws + WS_OCAT);
    const int lane = tid & 63, h = __builtin_amdgcn_readfirstlane(tid >> 6), n = lane & 15, g = lane >> 4;
    LAS float* BL = (LAS float*)(lds + L_BIAS);
    for (int i = tid; i < 8 * 15 * 31; i += 512) BL[i] = bias[i];
    __syncthreads();
    LAS unsigned char* vbuf = lds + h * CHUNK;
    const unsigned wroff = (unsigned)((lane >> 4) * VP + (lane & 15) * 16);
    const unsigned rd0 = (unsigned)((4 * g + (n >> 2)) * VP + (n & 3) * 8), rd1 = rd0 + 16u * VP;
    for (int it = vcu; it < NBATCH * 64 * 4; it += G) {
        const int cb = it & 3, r = (it >> 2) & 63, b = it >> 8, c0 = cb * 16;
        int rs = r - 4; rs = rs < 0 ? 0 : (rs > 56 ? 56 : rs);
        int start = c0 - 8; start = start < 0 ? 0 : (start > 32 ? 32 : start);
        const size_t tb = (size_t)b * SEQ;
        bf16x8 qreg[4];
        { const bf16_t* qp = QA + (tb + (size_t)r * GW_ + c0 + n) * 1024 + h * 128 + 8 * g;
#pragma unroll
          for (int ks = 0; ks < 4; ++ks) qreg[ks] = *(const bf16x8*)(qp + 32 * ks); }
        const bf16_t* kbase = KA + (tb + (size_t)rs * GW_ + start + n) * 1024 + h * 128 + 8 * g;
        const bf16_t* vbase = VA + (tb + (size_t)rs * GW_ + start + (lane >> 4)) * 1024 + h * 128 + (lane & 15) * 8;
        u32x4 vreg[8];
#define N3_VLOAD(W) do { _Pragma("unroll") for (int i = 0; i < 8; ++i) vreg[i] = *(const u32x4*)(vbase + (size_t)((W) * GW_ + 4 * i) * 1024); } while (0)
#define N3_KLOAD(KB, T_) do { const bf16_t* kp_ = kbase + (size_t)(((T_) >> 1) * GW_ + 16 * ((T_) & 1)) * 1024; _Pragma("unroll") for (int ks = 0; ks < 4; ++ks) KB[ks] = *(const bf16x8*)(kp_ + 32 * ks); } while (0)
#define N3_KMMA(KB, T_) do { f32x4 a_ = {0.f, 0.f, 0.f, 0.f}; _Pragma("unroll") for (int ks = 0; ks < 4; ++ks) a_ = __builtin_amdgcn_mfma_f32_16x16x32_bf16(KB[ks], qreg[ks], a_, 0, 0, 0); sc[T_] = a_; } while (0)
#define N3_FENCE() asm volatile("" ::: "memory")
        f32x4 sc[16];
        bf16x8 k0[4], k1[4], k2[4], k3[4];
        N3_KLOAD(k0, 0); N3_KLOAD(k1, 1); N3_KLOAD(k2, 2); N3_KLOAD(k3, 3); N3_FENCE();
        N3_KMMA(k0, 0); N3_KLOAD(k0, 4); N3_FENCE();  N3_KMMA(k1, 1); N3_KLOAD(k1, 5); N3_FENCE();  N3_KMMA(k2, 2); N3_KLOAD(k2, 6); N3_FENCE();  N3_KMMA(k3, 3); N3_KLOAD(k3, 7); N3_FENCE();
        N3_KMMA(k0, 4); N3_KLOAD(k0, 8); N3_FENCE();  N3_KMMA(k1, 5); N3_KLOAD(k1, 9); N3_FENCE();  N3_KMMA(k2, 6); N3_KLOAD(k2, 10); N3_FENCE(); N3_KMMA(k3, 7); N3_KLOAD(k3, 11); N3_FENCE();
        N3_KMMA(k0, 8); N3_KLOAD(k0, 12); N3_FENCE(); N3_KMMA(k1, 9); N3_KLOAD(k1, 13); N3_FENCE(); N3_KMMA(k2, 10); N3_KLOAD(k2, 14); N3_FENCE(); N3_KMMA(k3, 11); N3_KLOAD(k3, 15); N3_FENCE();
        N3_VLOAD(0); N3_FENCE();
        N3_KMMA(k0, 12); N3_KMMA(k1, 13); N3_KMMA(k2, 14); N3_KMMA(k3, 15);
        const int c = c0 + n; int cs = c - 8; cs = cs < 0 ? 0 : (cs > 48 ? 48 : cs);
        float mx = -1e30f;
#pragma unroll
        for (int T_ = 0; T_ < 16; ++T_) { const LAS float* brow = BL + (h * 15 + (rs + (T_ >> 1) - r + 7)) * 31;
#pragma unroll
            for (int rg = 0; rg < 4; ++rg) { const int kc = start + 16 * (T_ & 1) + 4 * g + rg; const bool valid = kc >= cs && kc < cs + 16; int dc = kc - c + 15; dc = dc < 0 ? 0 : (dc > 30 ? 30 : dc);
                const float v = valid ? sc[T_][rg] + brow[dc] : -1e30f; sc[T_][rg] = v; mx = fmaxf(mx, v); } }
        mx = fmaxf(mx, __shfl_xor(mx, 16)); mx = fmaxf(mx, __shfl_xor(mx, 32));
        float ls = 0.f;
#pragma unroll
        for (int T_ = 0; T_ < 16; ++T_)
#pragma unroll
            for (int rg = 0; rg < 4; ++rg) { const float p = sc[T_][rg] > -1e29f ? __builtin_amdgcn_exp2f((sc[T_][rg] - mx) * 1.4426950408889634f) : 0.f; sc[T_][rg] = p; ls += p; }
        ls += __shfl_xor(ls, 16); ls += __shfl_xor(ls, 32);
        const float inv = __builtin_amdgcn_rcpf(ls);
        bf16x8 pf[8];
#pragma unroll
        for (int w = 0; w < 8; ++w) { u32x4 pw; pw.x = cvt_pk_bf16(sc[2 * w][0], sc[2 * w][1]); pw.y = cvt_pk_bf16(sc[2 * w][2], sc[2 * w][3]); pw.z = cvt_pk_bf16(sc[2 * w + 1][0], sc[2 * w + 1][1]); pw.w = cvt_pk_bf16(sc[2 * w + 1][2], sc[2 * w + 1][3]);
            pf[w] = __builtin_bit_cast(bf16x8, pw); }
        f32x4 o[8];
#pragma unroll
        for (int dt = 0; dt < 8; ++dt) o[dt] = (f32x4){0.f, 0.f, 0.f, 0.f};
#pragma unroll
        for (int w = 0; w < 8; ++w) {
#pragma unroll
            for (int i = 0; i < 8; ++i) *(LAS u32x4*)(vbuf + wroff + (unsigned)(4 * i) * VP) = vreg[i];
            N3_FENCE();
            if (w + 1 < 8) N3_VLOAD(w + 1);
            asm volatile("s_waitcnt lgkmcnt(0)" ::: "memory");
#pragma unroll
            for (int dt = 0; dt < 8; ++dt) {
                const v4i16_t t0 = __builtin_amdgcn_ds_read_tr16_b64_v4i16((LAS v4i16_t*)(vbuf + rd0 + dt * 32));
                const v4i16_t t1 = __builtin_amdgcn_ds_read_tr16_b64_v4i16((LAS v4i16_t*)(vbuf + rd1 + dt * 32));
                const bf16x8 vf = (bf16x8){t0[0], t0[1], t0[2], t0[3], t1[0], t1[1], t1[2], t1[3]};
                o[dt] = __builtin_amdgcn_mfma_f32_16x16x32_bf16(pf[w], vf, o[dt], 0, 0, 0); }
            asm volatile("s_waitcnt lgkmcnt(0)" ::: "memory");
        }
        float iq[4];
#pragma unroll
        for (int rg = 0; rg < 4; ++rg) iq[rg] = __shfl(inv, 4 * g + rg);
#pragma unroll
        for (int rg = 0; rg < 4; ++rg) { bf16_t* op = OCAT + (tb + (size_t)r * GW_ + c0 + 4 * g + rg) * 3072 + h * 128 + n;
#pragma unroll
            for (int dt = 0; dt < 8; ++dt) op[16 * dt] = (bf16_t)f2bf(o[dt][rg] * iq[rg]); }
#undef N3_VLOAD
#undef N3_KLOAD
#undef N3_KMMA
#undef N3_FENCE
    }
    __syncthreads();
}
}

namespace sgu {
constexpr int VTROW = 288;
constexpr int L_ST = 0, L_VT = 1024, L_END = L_VT + 128 * VTROW;
__device__ __forceinline__ void phase(const int tid, unsigned char* ws, const bf16_t* W, const float* lng, const float* lnb, const float* bs, LAS unsigned char* lds, int G, int vcu) {
    const bf16_t* ZB = (const bf16_t*)(ws + WS_ZB); bf16_t* OCAT = (bf16_t*)(ws + WS_OCAT);
    const int lane = tid & 63, w = __builtin_amdgcn_readfirstlane(tid >> 6), n16 = lane & 15, g4 = lane >> 4;
    LAS f32x2* ST = (LAS f32x2*)(lds + L_ST);
    for (int it = vcu; it < NBATCH * 32 * 8; it += G) {
        const int g = it & 7, nb = it >> 3; const size_t tb = (size_t)nb * 128;
        if (lane < 16) { const int tok = 16 * w + lane; const float* zp = (const float*)(ws + WS_ZST) + (tb + tok) * 32; float s1 = 0.f, s2 = 0.f;
#pragma unroll
            for (int e = 0; e < 8; ++e) { const f32x4 v = *(const f32x4*)(zp + 4 * e); s1 += v[0] + v[2]; s2 += v[1] + v[3]; }
            const float mu = s1 * (1.f / 1024.f), var = fmaxf(s2 * (1.f / 1024.f) - mu * mu, 0.f);
            ST[tok] = (f32x2){mu, rsqrtf(var + EPS)}; }
        __syncthreads();
#pragma unroll
        for (int i = 0; i < 4; ++i) { const int id = tid + 512 * i, q = id & 127, cc = id >> 7; const f32x2 st = ST[q];
            const u32x4 a = *(const u32x4*)(ZB + (tb + q) * 2048 + 1024 + g * 128 + cc * 8);
            const f32x4 g0 = *(const f32x4*)(lng + g * 128 + cc * 8), g1 = *(const f32x4*)(lng + g * 128 + cc * 8 + 4), b0 = *(const f32x4*)(lnb + g * 128 + cc * 8), b1 = *(const f32x4*)(lnb + g * 128 + cc * 8 + 4);
            LAS unsigned short* vt = (LAS unsigned short*)(lds + L_VT + (cc * 8) * VTROW + q * 2);
#pragma unroll
            for (int e = 0; e < 4; ++e) { const float x0 = (bf2f(a[e] & 0xffffu) - st.x) * st.y, x1 = (bf2f(a[e] >> 16) - st.x) * st.y;
                const float y0 = x0 * (e < 2 ? g0[2 * e] : g1[2 * e - 4]) + (e < 2 ? b0[2 * e] : b1[2 * e - 4]), y1 = x1 * (e < 2 ? g0[2 * e + 1] : g1[2 * e - 3]) + (e < 2 ? b0[2 * e + 1] : b1[2 * e - 3]);
                const unsigned pk = cvt_pk_bf16(y0, y1);
                vt[(2 * e) * (VTROW / 2)] = (unsigned short)(pk & 0xffffu); vt[(2 * e + 1) * (VTROW / 2)] = (unsigned short)(pk >> 16); } }
        __syncthreads();
        f32x4 acc[8];
#pragma unroll
        for (int nt = 0; nt < 8; ++nt) acc[nt] = (f32x4){0.f, 0.f, 0.f, 0.f};
        const bf16_t* wp = W + ((size_t)g * 128 + 16 * w + n16) * 128 + 8 * g4;
#pragma unroll
        for (int ks = 0; ks < 4; ++ks) { const bf16x8 af = *(const bf16x8*)(wp + 32 * ks);
#pragma unroll
            for (int nt = 0; nt < 8; ++nt) { const bf16x8 bf = *(const LAS bf16x8*)(lds + L_VT + (16 * nt + n16) * VTROW + (32 * ks + 8 * g4) * 2);
                acc[nt] = __builtin_amdgcn_mfma_f32_16x16x32_bf16(af, bf, acc[nt], 0, 0, 0); } }
#pragma unroll
        for (int rg = 0; rg < 4; ++rg) { const int p = 16 * w + 4 * g4 + rg; const float bb = bs[g * 128 + p]; const size_t tok = tb + p;
#pragma unroll
            for (int nt = 0; nt < 8; ++nt) { const int c = 16 * nt + n16; const float u = bf2f((unsigned)ZB[tok * 2048 + g * 128 + c]);
                OCAT[tok * 3072 + 1024 + g * 128 + c] = (bf16_t)f2bf(u * (acc[nt][rg] + bb)); } }
        __syncthreads();
    }
}
}


namespace psel {
using f32x16 = __attribute__((ext_vector_type(16))) float;
__device__ __forceinline__ int sortable(float f) { int s = __float_as_int(f); return s ^ ((s >> 31) & 0x7fffffff); }
__device__ __forceinline__ float unsort(int k) { return __int_as_float(k ^ ((k >> 31) & 0x7fffffff)); }
__device__ __forceinline__ int imax(int a, int b) { return a > b ? a : b; }
__device__ __forceinline__ int imin(int a, int b) { return a < b ? a : b; }
#define PS_INS(L, x) do { int v_ = (x); _Pragma("unroll") for (int i_ = 0; i_ < 16; ++i_) { const int h_ = imax(L[i_], v_); v_ = imin(L[i_], v_); L[i_] = h_; } } while (0)
#define PS_STAGE(c_, D) do { _Pragma("unroll") for (int i_ = 0; i_ < 16; ++i_) if ((i_ & (D)) == 0) { const int h_ = imax(c_[i_], c_[i_ + (D)]), l_ = imin(c_[i_], c_[i_ + (D)]); c_[i_] = h_; c_[i_ + (D)] = l_; } } while (0)
#define PS_MERGE(L) do { int c_[16]; _Pragma("unroll") for (int i_ = 0; i_ < 16; ++i_) c_[i_] = imax(L[i_], __shfl_xor(L[15 - i_], 32)); \
    PS_STAGE(c_, 8); PS_STAGE(c_, 4); PS_STAGE(c_, 2); PS_STAGE(c_, 1); \
    _Pragma("unroll") for (int i_ = 0; i_ < 16; ++i_) L[i_] = c_[i_]; } while (0)
#define PS_CAS(a, b) do { const int h__ = imax(a, b), l__ = imin(a, b); a = h__; b = l__; } while (0)
#define PS_BST(c, K, J) do { _Pragma("unroll") for (int i_ = 0; i_ < 16; ++i_) { if ((i_ ^ (J)) > i_) { if ((i_ & (K)) == 0) PS_CAS(c[i_], c[i_ ^ (J)]); else PS_CAS(c[i_ ^ (J)], c[i_]); } } } while (0)
__device__ __forceinline__ void sort16(int (&c)[16]) {
    PS_BST(c, 2, 1); PS_BST(c, 4, 2); PS_BST(c, 4, 1); PS_BST(c, 8, 4); PS_BST(c, 8, 2); PS_BST(c, 8, 1); PS_BST(c, 16, 8); PS_BST(c, 16, 4); PS_BST(c, 16, 2); PS_BST(c, 16, 1);
}
__device__ __forceinline__ void merge16(int (&L)[16], const int (&c)[16]) {
#pragma unroll
    for (int i = 0; i < 16; ++i) L[i] = imax(L[i], c[15 - i]);
    PS_STAGE(L, 8); PS_STAGE(L, 4); PS_STAGE(L, 2); PS_STAGE(L, 1);
}
__device__ __forceinline__ int sel16(const int (&v)[16], int i) { int r = v[0];
#pragma unroll
    for (int k = 1; k < 16; ++k) { r = (i == k) ? v[k] : r; asm volatile("" : "+v"(r)); }
    return r; }
__device__ __forceinline__ void side_list(int (&L)[16], const f32x4 (&sc)[16], int hi) {
    const int nb = 127 - 64 * hi;
#pragma unroll
    for (int q = 0; q < 4; ++q) {
        int c[16];
#pragma unroll
        for (int j = 0; j < 4; ++j) { c[j] = (sortable(sc[4 * q][j]) & ~127) | (nb - (16 * q + j)); c[4 + j] = (sortable(sc[4 * q + 1][j]) & ~127) | (nb - (16 * q + 4 + j));
            c[8 + j] = (sortable(sc[4 * q + 2][j]) & ~127) | (nb - (16 * q + 8 + j)); c[12 + j] = (sortable(sc[4 * q + 3][j]) & ~127) | (nb - (16 * q + 12 + j)); }
        sort16(c);
        if (q == 0) {
#pragma unroll
            for (int i = 0; i < 16; ++i) L[i] = c[i];
        } else merge16(L, c);
    }
    PS_MERGE(L);
}
template <bool TILE> __device__ __forceinline__ void phase(const int tid, unsigned char* ws, int G, int vcu, int pm, int hh) {
    const float* SC = (const float*)(ws + WS_SC); int* IDX = (int*)(ws + WS_IDX); float* GWT = (float*)(ws + WS_GW);
    const int lane = tid & 63, wave = __builtin_amdgcn_readfirstlane(tid >> 6), r32 = lane & 31, hi = lane >> 5;
    for (int task = TILE ? wave : vcu * NWAVES + wave; task < (TILE ? NWAVES : (T / 32) * 8); task += (TILE ? NWAVES : G * NWAVES)) {
        const int h = TILE ? hh : (task & 7), t0 = TILE ? pm * 256 + 32 * task : (task >> 3) * 32, t = t0 + r32;
        int v1[16], v2[16];
        f32x4 sa[16], sb[16];
        { const bf16_t* sp = (const bf16_t*)SC + (size_t)t * 2048 + h * 256 + 64 * hi; u32x4 wa_[8], wb_[8];
#pragma unroll
          for (int q = 0; q < 8; ++q) { wa_[q] = *(const u32x4*)(sp + 8 * q); wb_[q] = *(const u32x4*)(sp + 128 + 8 * q); }
#pragma unroll
          for (int q = 0; q < 8; ++q) { sa[2 * q] = (f32x4){bf2f(wa_[q][0] & 0xffffu), bf2f(wa_[q][0] >> 16), bf2f(wa_[q][1] & 0xffffu), bf2f(wa_[q][1] >> 16)}; sa[2 * q + 1] = (f32x4){bf2f(wa_[q][2] & 0xffffu), bf2f(wa_[q][2] >> 16), bf2f(wa_[q][3] & 0xffffu), bf2f(wa_[q][3] >> 16)};
              sb[2 * q] = (f32x4){bf2f(wb_[q][0] & 0xffffu), bf2f(wb_[q][0] >> 16), bf2f(wb_[q][1] & 0xffffu), bf2f(wb_[q][1] >> 16)}; sb[2 * q + 1] = (f32x4){bf2f(wb_[q][2] & 0xffffu), bf2f(wb_[q][2] >> 16), bf2f(wb_[q][3] & 0xffffu), bf2f(wb_[q][3] >> 16)}; } }
        side_list(v1, sa, hi);
        side_list(v2, sb, hi);
        float f1[16], f2[16];
#pragma unroll
        for (int i = 0; i < 16; ++i) { f1[i] = unsort(v1[i] & ~127); f2[i] = unsort(v2[i] & ~127); }
#define PS_CAND(I, J) ((sortable(f1[I] + f2[J]) & ~255) | (255 - ((I) * 16 + (J))))
        int C[16];
#pragma unroll
        for (int j = 0; j < 16; ++j) C[j] = PS_CAND(0, j);
        { int c[16];
#pragma unroll
          for (int j = 0; j < 8; ++j) c[j] = PS_CAND(1, j);
#pragma unroll
          for (int j = 0; j < 5; ++j) c[8 + j] = PS_CAND(2, j);
#pragma unroll
          for (int j = 0; j < 3; ++j) c[13 + j] = PS_CAND(3, j);
          sort16(c); merge16(C, c); }
        { int c[16];
          c[0] = PS_CAND(3, 3);
#pragma unroll
          for (int j = 0; j < 3; ++j) c[1 + j] = PS_CAND(4, j);
#pragma unroll
          for (int j = 0; j < 2; ++j) { c[4 + j] = PS_CAND(5, j); c[6 + j] = PS_CAND(6, j); c[8 + j] = PS_CAND(7, j); }
          c[10] = PS_CAND(8, 0); c[11] = PS_CAND(9, 0); c[12] = PS_CAND(10, 0); c[13] = PS_CAND(11, 0); c[14] = PS_CAND(12, 0); c[15] = PS_CAND(13, 0);
          sort16(c); merge16(C, c); }
        PS_INS(C, PS_CAND(14, 0)); PS_INS(C, PS_CAND(15, 0));
#undef PS_CAND
        const float b0 = unsort(C[0] & ~255); float e[16], sum = 0.f;
#pragma unroll
        for (int k = 0; k < 16; ++k) { e[k] = __expf(unsort(C[k] & ~255) - b0); sum += e[k]; }
        const float inv = 1.f / sum;
        int oi[8]; float og[8];
        const int hm = -hi;
#pragma unroll
        for (int k = 0; k < 8; ++k) { const int ck = (C[k] & ~hm) | (C[8 + k] & hm); const int code = 255 - (ck & 255), n1 = 127 - (sel16(v1, code >> 4) & 127), n2 = 127 - (sel16(v2, code & 15) & 127);
            oi[k] = n1 * 128 + n2; og[k] = __int_as_float((__float_as_int(e[k]) & ~hm) | (__float_as_int(e[8 + k]) & hm)) * inv; }
        int* ip = IDX + (size_t)t * 128 + h * 16 + 8 * hi; float* gp = GWT + (size_t)t * 128 + h * 16 + 8 * hi;
        *(u32x4*)ip = (u32x4){(unsigned)oi[0], (unsigned)oi[1], (unsigned)oi[2], (unsigned)oi[3]}; *(u32x4*)(ip + 4) = (u32x4){(unsigned)oi[4], (unsigned)oi[5], (unsigned)oi[6], (unsigned)oi[7]};
        *(f32x4*)gp = (f32x4){og[0], og[1], og[2], og[3]}; *(f32x4*)(gp + 4) = (f32x4){og[4], og[5], og[6], og[7]};
    }
}
#undef PS_INS
#undef PS_MERGE
#undef PS_STAGE
#undef PS_CAS
#undef PS_BST
}


template <bool USEPART> __device__ __forceinline__ void peer_gather8_phase(const int tid, unsigned char* ws, const unsigned char* pu, const unsigned char* pv, const float* final_g, float* out, int G, int vcu) {
    const int lane = tid & 63, wave = __builtin_amdgcn_readfirstlane(tid >> 6), hi = lane >> 5, sel = (lane >> 4) & 1;
    const float* RS2 = (const float*)(ws + WS_RS2); const int* IDX = (const int*)(ws + WS_IDX); const float* GWT = (const float*)(ws + WS_GW);
    float* X = (float*)(ws + WS_X); bf16_t* XB = (bf16_t*)(ws + WS_XB); float* RS = (float*)(ws + WS_RS);
    const bool local = (G * NWAVES * 4 == T);
    for (int it = 0; it < (local ? 4 : (T + G * NWAVES - 1) / (G * NWAVES)); ++it) { const int t = local ? 32 * vcu + 4 * wave + it : vcu * NWAVES + wave + it * G * NWAVES; if (t >= T) break;
        float xf[2][16];
#pragma unroll
        for (int c = 0; c < 2; ++c)
#pragma unroll
            for (int q = 0; q < 4; ++q) { const f32x4 v = *(const f32x4*)(X + (size_t)t * DM + c * 1024 + lane * 16 + 4 * q); xf[c][4 * q] = v[0]; xf[c][4 * q + 1] = v[1]; xf[c][4 * q + 2] = v[2]; xf[c][4 * q + 3] = v[3]; }
        const float rs2 = __hip_atomic_load(RS2 + t, __ATOMIC_RELAXED, __HIP_MEMORY_SCOPE_AGENT);
        const int e_lo = IDX[(size_t)t * 128 + lane], e_hi = IDX[(size_t)t * 128 + 64 + lane];
        const float g_lo = GWT[(size_t)t * 128 + lane], g_hi = GWT[(size_t)t * 128 + 64 + lane];
        float a_lo = 0.f, a_hi = 0.f;
#define P8_LOAD(R, tab, kk) do { _Pragma("unroll") for (int i = 0; i < 2; ++i) { const int e = __builtin_amdgcn_readlane((kk) < 64 ? e_lo : e_hi, ((kk) & 63) + i); const unsigned char* row = (tab) + (size_t)e * DM + lane * 16; \
            R[i][0] = *(const u32x4*)row; R[i][1] = *(const u32x4*)(row + 1024); } } while (0)
#define P8_DOT(R, kk) do { float p[2]; _Pragma("unroll") for (int i = 0; i < 2; ++i) { float s0 = 0.f, s1 = 0.f; \
            _Pragma("unroll") for (int c = 0; c < 2; ++c) _Pragma("unroll") for (int q = 0; q < 4; ++q) { const f32x2 lo = __builtin_amdgcn_cvt_pk_f32_fp8(R[i][c][q], false), hh = __builtin_amdgcn_cvt_pk_f32_fp8(R[i][c][q], true); \
                s0 += xf[c][4 * q] * lo.x + xf[c][4 * q + 1] * lo.y; s1 += xf[c][4 * q + 2] * hh.x + xf[c][4 * q + 3] * hh.y; } p[i] = s0 + s1; } \
            float rr = (hi ? p[1] : p[0]) + __shfl_xor(hi ? p[0] : p[1], 32); rr += __shfl_xor(rr, 16); rr += __shfl_xor(rr, 8); rr += __shfl_xor(rr, 4); rr += __shfl_xor(rr, 2); rr += __shfl_xor(rr, 1); \
            const int k2 = (kk) & 63; const float v_ = __shfl(rr, ((lane - k2) & 1) * 32); if (lane >= k2 && lane < k2 + 2) { if ((kk) < 64) a_lo = v_; else a_hi = v_; } } while (0)
#define P8_AXPY(R, kk) do { _Pragma("unroll") for (int i = 0; i < 2; ++i) { const float wk = __uint_as_float(__builtin_amdgcn_readlane(__float_as_uint((kk) < 64 ? w_lo : w_hi), ((kk) & 63) + i)); \
            _Pragma("unroll") for (int c = 0; c < 2; ++c) _Pragma("unroll") for (int q = 0; q < 4; ++q) { const f32x2 lo = __builtin_amdgcn_cvt_pk_f32_fp8(R[i][c][q], false), hh = __builtin_amdgcn_cvt_pk_f32_fp8(R[i][c][q], true); \
                y[c][4 * q] += wk * lo.x; y[c][4 * q + 1] += wk * lo.y; y[c][4 * q + 2] += wk * hh.x; y[c][4 * q + 3] += wk * hh.y; } } } while (0)
#define P8_FENCE() asm volatile("" ::: "memory")
        u32x4 rA[2][2], rB[2][2];
        if constexpr (USEPART) {
            const float* pp = (const float*)(ws + WS_PART) + (size_t)t * 128 + lane;
#pragma unroll
            for (int x_ = 0; x_ < 8; ++x_) { a_lo += pp[(size_t)x_ * T * 128]; a_hi += pp[(size_t)x_ * T * 128 + 64]; }
        } else {
        P8_LOAD(rA, pu, 0); P8_FENCE();
        for (int k0 = 0; k0 < 128; k0 += 4) {
            P8_LOAD(rB, pu, k0 + 2); P8_FENCE();
            P8_DOT(rA, k0); P8_FENCE();
            if (k0 + 4 < 128) P8_LOAD(rA, pu, k0 + 4);
            P8_FENCE();
            P8_DOT(rB, k0 + 2); P8_FENCE();
        }
        }
        P8_LOAD(rA, pv, 0); P8_FENCE();
        const float w_lo = gelu_tanh(rs2 * (1.f / PU_SCALE) * a_lo) * g_lo, w_hi = gelu_tanh(rs2 * (1.f / PU_SCALE) * a_hi) * g_hi;
        float y[2][16];
#pragma unroll
        for (int c = 0; c < 2; ++c)
#pragma unroll
            for (int j = 0; j < 16; ++j) y[c][j] = 0.f;
        for (int k0 = 0; k0 < 128; k0 += 4) {
            P8_LOAD(rB, pv, k0 + 2); P8_FENCE();
            P8_AXPY(rA, k0); P8_FENCE();
            if (k0 + 4 < 128) P8_LOAD(rA, pv, k0 + 4);
            P8_FENCE();
            P8_AXPY(rB, k0 + 2); P8_FENCE();
        }
#undef P8_LOAD
#undef P8_DOT
#undef P8_AXPY
#undef P8_FENCE
        float ss = 0.f;
#pragma unroll
        for (int c = 0; c < 2; ++c)
#pragma unroll
            for (int j = 0; j < 16; ++j) { y[c][j] = xf[c][j] + y[c][j] * (1.f / PV_SCALE); ss += y[c][j] * y[c][j]; }
        const float rn = rsqrtf(wave_sum(ss) * (1.f / DM) + EPS);
        float am = 0.f;
        if (!out) {
#pragma unroll
            for (int c = 0; c < 2; ++c)
#pragma unroll
                for (int j = 0; j < 16; ++j) am = fmaxf(am, fabsf(y[c][j]));
#pragma unroll
            for (int o_ = 1; o_ < 64; o_ <<= 1) am = fmaxf(am, __shfl_xor(am, o_)); }
        const float qinv = am > 0.f ? 127.f / am : 0.f;
        int lo16 = lane * 16; asm volatile("" : "+v"(lo16));
#pragma unroll
        for (int c = 0; c < 2; ++c) { const size_t off = (size_t)t * DM + c * 1024 + lo16;
            if (out) {
#pragma unroll
                for (int q = 0; q < 4; ++q) { const f32x4 gq = *(const f32x4*)(final_g + c * 1024 + lo16 + 4 * q);
                    *(f32x4*)(out + off + 4 * q) = (f32x4){y[c][4 * q] * rn * gq[0], y[c][4 * q + 1] * rn * gq[1], y[c][4 * q + 2] * rn * gq[2], y[c][4 * q + 3] * rn * gq[3]}; }
            } else {
#pragma unroll
                for (int q = 0; q < 4; ++q) *(f32x4*)(X + off + 4 * q) = (f32x4){y[c][4 * q], y[c][4 * q + 1], y[c][4 * q + 2], y[c][4 * q + 3]};
                store8_bf16(XB + off, (f32x4){y[c][0], y[c][1], y[c][2], y[c][3]}, (f32x4){y[c][4], y[c][5], y[c][6], y[c][7]});
                store8_bf16(XB + off + 8, (f32x4){y[c][8], y[c][9], y[c][10], y[c][11]}, (f32x4){y[c][12], y[c][13], y[c][14], y[c][15]});
                *(u32x4*)(ws + WS_XQ + off) = (u32x4){pack4_q8(y[c][0] * qinv, y[c][1] * qinv, y[c][2] * qinv, y[c][3] * qinv), pack4_q8(y[c][4] * qinv, y[c][5] * qinv, y[c][6] * qinv, y[c][7] * qinv),
                                                     pack4_q8(y[c][8] * qinv, y[c][9] * qinv, y[c][10] * qinv, y[c][11] * qinv), pack4_q8(y[c][12] * qinv, y[c][13] * qinv, y[c][14] * qinv, y[c][15] * qinv)};
            } }
        if (!out && lane == 0) { RS[t] = rn; ((float*)(ws + WS_SA))[t] = am * (1.f / 127.f); }
    }
}


namespace krp {
using f32x16 = __attribute__((ext_vector_type(16))) float;
__device__ __forceinline__ void phase(const int tid, unsigned char* ws, const bf16_t* WKR, LAS unsigned char* lds, int G, int vcu) {
    const bf16_t* XB = (const bf16_t*)(ws + WS_XB); const float* RS = (const float*)(ws + WS_RS); const f32x2* rope = (const f32x2*)(ws + WS_ROPE); bf16_t* KF = (bf16_t*)(ws + WS_KF);
    const int lane = tid & 63, w = __builtin_amdgcn_readfirstlane(tid >> 6), r32 = lane & 31, hi = lane >> 5;
    LAS float* P = (LAS float*)lds;
    for (int task = vcu; task < T / 32; task += G) {
        const int t0 = task * 32;
        f32x16 acc0 = {}, acc1 = {};
        const bf16_t* xp = XB + (size_t)(t0 + r32) * DM + 256 * w + 8 * hi; const bf16_t* wp = WKR + (size_t)r32 * DM + 256 * w + 8 * hi;
#pragma unroll
        for (int ks = 0; ks < 16; ++ks) { const bf16x8 b = *(const bf16x8*)(xp + 16 * ks), a0 = *(const bf16x8*)(wp + 16 * ks), a1 = *(const bf16x8*)(wp + (size_t)32 * DM + 16 * ks);
            acc0 = __builtin_amdgcn_mfma_f32_32x32x16_bf16(a0, b, acc0, 0, 0, 0); acc1 = __builtin_amdgcn_mfma_f32_32x32x16_bf16(a1, b, acc1, 0, 0, 0); }
        __syncthreads();
#pragma unroll
        for (int r = 0; r < 16; ++r) { P[((w * 2 + 0) * 16 + r) * 64 + lane] = acc0[r]; P[((w * 2 + 1) * 16 + r) * 64 + lane] = acc1[r]; }
        __syncthreads();
        const int tok = tid & 31, tile = (tid >> 5) & 1, jq = tid >> 6, src = tok + 32 * (jq & 1);
        float v[4] = {0.f, 0.f, 0.f, 0.f};
#pragma unroll
        for (int ww = 0; ww < 8; ++ww)
#pragma unroll
            for (int c = 0; c < 4; ++c) v[c] += P[((ww * 2 + tile) * 16 + 4 * (jq >> 1) + c) * 64 + src];
        const int t = t0 + tok, jg = 32 * tile + 4 * jq; const float rs = RS[t];
        const f32x2 c0 = rope[(size_t)(t & (SEQ - 1)) * 32 + (jg >> 1)], c1 = rope[(size_t)(t & (SEQ - 1)) * 32 + (jg >> 1) + 1];
        const float x0 = v[0] * rs, x1 = v[1] * rs, x2 = v[2] * rs, x3 = v[3] * rs;
        u32x2 o; o.x = cvt_pk_bf16(x0 * c0.x - x1 * c0.y, x1 * c0.x + x0 * c0.y); o.y = cvt_pk_bf16(x2 * c1.x - x3 * c1.y, x3 * c1.x + x2 * c1.y);
#pragma unroll
        for (int h = 0; h < 8; ++h) *(u32x2*)(KF + (size_t)t * 1536 + h * 192 + 128 + jg) = o;
    }
    __syncthreads();
}
}


template <int CTRL> __device__ __forceinline__ float dpp_add(float v) { return v + __int_as_float(__builtin_amdgcn_update_dpp(0, __float_as_int(v), CTRL, 0xf, 0xf, true)); }
__device__ __forceinline__ float row16_sum(float v) { v = dpp_add<0xB1>(v); v = dpp_add<0x4E>(v); v = dpp_add<0x141>(v); v = dpp_add<0x140>(v); return v; }
__device__ __forceinline__ void peer_u_sliced_phase(const int tid, unsigned char* ws, const unsigned char* pu, int G, int vcu) {
    const int lane = tid & 63, wave = __builtin_amdgcn_readfirstlane(tid >> 6), q = lane >> 4, j = lane & 15;
    const int wps = G / 8, xs = vcu / wps, wi = (vcu % wps) * NWAVES + wave, nws = wps * NWAVES;
    if (xs >= 8) return;
    const float* X = (const float*)(ws + WS_X); const int* IDX = (const int*)(ws + WS_IDX); unsigned* PART = (unsigned*)(ws + WS_PART) + (size_t)xs * T * 64;
    const unsigned ub = (unsigned)(256 * xs + 16 * j);
    int e_lo_n = 0, e_hi_n = 0; u32x4 w0n = {0u, 0u, 0u, 0u}, w1n = {0u, 0u, 0u, 0u};
#define US_HEAD(tt) do { const bf16_t* xp = (const bf16_t*)(ws + WS_XB) + (size_t)(tt) * DM + 256 * xs + 16 * j; w0n = *(const u32x4*)xp; w1n = *(const u32x4*)(xp + 8); \
        e_lo_n = IDX[(size_t)(tt) * 128 + lane]; e_hi_n = IDX[(size_t)(tt) * 128 + 64 + lane]; } while (0)
    if (wi < T) US_HEAD(wi);
    for (int t = wi; t < T; t += nws) {
        f32x2 xv[8];
        { const u32x4 w0 = w0n, w1 = w1n;
#pragma unroll
          for (int c = 0; c < 4; ++c) { xv[c] = (f32x2){bf2f(w0[c] & 0xffffu), bf2f(w0[c] >> 16)}; xv[4 + c] = (f32x2){bf2f(w1[c] & 0xffffu), bf2f(w1[c] >> 16)}; } }
        const int e_lo = e_lo_n, e_hi = e_hi_n;
        float r0 = 0.f, r1 = 0.f;
#define US_LOAD(R, I0) do { _Pragma("unroll") for (int i = 0; i < 8; ++i) { const int e = __shfl((I0) < 16 ? e_lo : e_hi, (4 * ((I0) + i) + q) & 63); R[i] = *(const u32x4*)(pu + (((unsigned)e << 11) + ub)); } } while (0)
#define US_DOT(R, I0) do { _Pragma("unroll") for (int i = 0; i < 8; ++i) { f32x2 s0 = {0.f, 0.f}, s1 = {0.f, 0.f}; \
            _Pragma("unroll") for (int c = 0; c < 4; ++c) { const f32x2 lo = __builtin_amdgcn_cvt_pk_f32_fp8(R[i][c], false), hh = __builtin_amdgcn_cvt_pk_f32_fp8(R[i][c], true); \
                s0 = __builtin_elementwise_fma(xv[2 * c], lo, s0); s1 = __builtin_elementwise_fma(xv[2 * c + 1], hh, s1); } \
            s0 += s1; const float v_ = row16_sum(s0.x + s0.y); if ((I0) < 16) r0 = (j == (((I0) + i) & 15)) ? v_ : r0; else r1 = (j == (((I0) + i) & 15)) ? v_ : r1; } } while (0)
        u32x4 ra[8], rb[8];
        US_LOAD(ra, 0); asm volatile("" ::: "memory");
        US_LOAD(rb, 8); asm volatile("" ::: "memory");
        if (t + nws < T) US_HEAD(t + nws);
        asm volatile("" ::: "memory");
        US_DOT(ra, 0); asm volatile("" ::: "memory");
        US_LOAD(ra, 16); asm volatile("" ::: "memory");
        US_DOT(rb, 8); asm volatile("" ::: "memory");
        US_LOAD(rb, 24); asm volatile("" ::: "memory");
        US_DOT(ra, 16); asm volatile("" ::: "memory");
        US_DOT(rb, 24);
#undef US_LOAD
#undef US_DOT
#undef US_HEAD
        PART[(size_t)t * 64 + 4 * j + q] = cvt_pk_bf16(r0, r1);
    }
}

__device__ __forceinline__ void peer_v_sliced_phase(const int tid, unsigned char* ws, const unsigned char* pv, int G, int vcu) {
    const int lane = tid & 63, wave = __builtin_amdgcn_readfirstlane(tid >> 6), q = lane >> 4, j = lane & 15;
    const int wps = G / 8, xs = vcu / wps, wi = (vcu % wps) * NWAVES + wave, nws = wps * NWAVES;
    const int* IDX = (const int*)(ws + WS_IDX); const float* GWT = (const float*)(ws + WS_GW); const unsigned* PART = (const unsigned*)(ws + WS_PART); const float* RS2 = (const float*)(ws + WS_RS2);
    float* XSS = (float*)(ws + WS_XSS);
    if (xs >= 8) return;
    const unsigned vb = (unsigned)(256 * xs + 16 * j);
    int e_lo_n = 0, e_hi_n = 0; unsigned pp_n[8]; float g_lo_n = 0.f, g_hi_n = 0.f, rs2_n = 0.f;
#pragma unroll
    for (int x_ = 0; x_ < 8; ++x_) pp_n[x_] = 0u;
#define VS_HEAD(tt) do { const unsigned* pp = PART + (size_t)(tt) * 64 + lane; e_lo_n = IDX[(size_t)(tt) * 128 + lane]; e_hi_n = IDX[(size_t)(tt) * 128 + 64 + lane]; \
        _Pragma("unroll") for (int x_ = 0; x_ < 8; ++x_) pp_n[x_] = pp[(size_t)x_ * T * 64]; \
        rs2_n = __hip_atomic_load(RS2 + (tt), __ATOMIC_RELAXED, __HIP_MEMORY_SCOPE_AGENT); g_lo_n = GWT[(size_t)(tt) * 128 + lane]; g_hi_n = GWT[(size_t)(tt) * 128 + 64 + lane]; } while (0)
    if (wi < T) VS_HEAD(wi);
    for (int t = wi; t < T; t += nws) {
        const int e_lo = e_lo_n, e_hi = e_hi_n;
        float a_lo = 0.f, a_hi = 0.f;
#pragma unroll
        for (int x_ = 0; x_ < 8; ++x_) { a_lo += bf2f(pp_n[x_] & 0xffffu); a_hi += bf2f(pp_n[x_] >> 16); }
        const float rs2 = rs2_n;
        const float w_lo = gelu_tanh(rs2 * (1.f / PU_SCALE) * a_lo) * g_lo_n, w_hi = gelu_tanh(rs2 * (1.f / PU_SCALE) * a_hi) * g_hi_n;
        f32x2 y2[8];
#pragma unroll
        for (int i = 0; i < 8; ++i) y2[i] = (f32x2){0.f, 0.f};
        const int pk_lo = (int)((cvt_pk_bf16(0.f, w_lo) & 0xffff0000u) | (unsigned)e_lo), pk_hi = (int)((cvt_pk_bf16(0.f, w_hi) & 0xffff0000u) | (unsigned)e_hi);
#define VS_LOAD(R, P, I0) do { _Pragma("unroll") for (int i = 0; i < 8; ++i) { P[i] = __shfl((I0) < 16 ? pk_lo : pk_hi, (4 * ((I0) + i) + q) & 63); R[i] = *(const u32x4*)(pv + ((((unsigned)P[i] & 0xffffu) << 11) + vb)); } } while (0)
#define VS_AXPY(R, P, I0) do { _Pragma("unroll") for (int i = 0; i < 8; ++i) { const float wk = __uint_as_float((unsigned)P[i] & 0xffff0000u); \
            const f32x2 wk2 = {wk, wk}; \
            _Pragma("unroll") for (int c = 0; c < 4; ++c) { const f32x2 lo = __builtin_amdgcn_cvt_pk_f32_fp8(R[i][c], false), hh = __builtin_amdgcn_cvt_pk_f32_fp8(R[i][c], true); \
                y2[2 * c] = __builtin_elementwise_fma(wk2, lo, y2[2 * c]); y2[2 * c + 1] = __builtin_elementwise_fma(wk2, hh, y2[2 * c + 1]); } } } while (0)
        u32x4 ra[8], rb[8]; int pa[8], pb[8];
        VS_LOAD(ra, pa, 0); asm volatile("" ::: "memory");
        const u32x2 xw = *(const u32x2*)((const bf16_t*)(ws + WS_XB) + (size_t)t * DM + 256 * xs + 16 * j + 4 * q);
        if (t + nws < T) VS_HEAD(t + nws);
        asm volatile("" ::: "memory");
#pragma unroll 1
        for (int g0 = 0; g0 < 32; g0 += 16) {
            VS_LOAD(rb, pb, g0 + 8); asm volatile("" ::: "memory");
            VS_AXPY(ra, pa, g0); asm volatile("" ::: "memory");
            if (g0 + 16 < 32) VS_LOAD(ra, pa, g0 + 16);
            asm volatile("" ::: "memory");
            VS_AXPY(rb, pb, g0 + 8); asm volatile("" ::: "memory");
        }
#undef VS_LOAD
#undef VS_AXPY
#undef VS_HEAD
        float y[16];
#pragma unroll
        for (int i = 0; i < 8; ++i) { y[2 * i] = y2[i].x; y[2 * i + 1] = y2[i].y; }
#pragma unroll
        for (int i = 0; i < 16; ++i) { y[i] += __shfl_xor(y[i], 16); y[i] += __shfl_xor(y[i], 32); }
        f32x4 mine;
#pragma unroll
        for (int i = 0; i < 4; ++i) { float v = y[i]; v = (q == 1) ? y[4 + i] : v; asm volatile("" : "+v"(v)); v = (q == 2) ? y[8 + i] : v; asm volatile("" : "+v"(v)); v = (q == 3) ? y[12 + i] : v; asm volatile("" : "+v"(v)); mine[i] = v; }
        const f32x4 x1 = {bf2f(xw.x & 0xffffu), bf2f(xw.x >> 16), bf2f(xw.y & 0xffffu), bf2f(xw.y >> 16)}; const f32x4 of = x1 + mine * (1.f / PV_SCALE);
        const u32x2 ow = {cvt_pk_bf16(of[0], of[1]), cvt_pk_bf16(of[2], of[3])};
        *(u32x2*)((bf16_t*)(ws + WS_XB) + (size_t)t * DM + 256 * xs + 16 * j + 4 * q) = ow;
        const f32x4 o = {bf2f(ow.x & 0xffffu), bf2f(ow.x >> 16), bf2f(ow.y & 0xffffu), bf2f(ow.y >> 16)};
        float ss = (o[0] * o[0] + o[1] * o[1]) + (o[2] * o[2] + o[3] * o[3]), am = fmaxf(fmaxf(fabsf(o[0]), fabsf(o[1])), fmaxf(fabsf(o[2]), fabsf(o[3])));
        ss = wave_sum(ss);
#pragma unroll
        for (int o_ = 1; o_ < 64; o_ <<= 1) am = fmaxf(am, __shfl_xor(am, o_));
        if (lane == 0) { XSS[(size_t)t * 32 + xs] = ss; XSS[(size_t)t * 32 + 8 + xs] = am; }
    }
}
__device__ __forceinline__ void peer_finish_phase(const int tid, unsigned char* ws, const float* final_g, float* out, int G, int vcu) {
    const int lane = tid & 63, wave = __builtin_amdgcn_readfirstlane(tid >> 6);
    const bf16_t* XB = (const bf16_t*)(ws + WS_XB); float* RS = (float*)(ws + WS_RS); const float* XSS = (const float*)(ws + WS_XSS);
    for (int t = vcu * NWAVES + wave; t < T; t += G * NWAVES) {
        const f32x4 s0 = *(const f32x4*)(XSS + (size_t)t * 32), s1 = *(const f32x4*)(XSS + (size_t)t * 32 + 4), m0 = *(const f32x4*)(XSS + (size_t)t * 32 + 8), m1 = *(const f32x4*)(XSS + (size_t)t * 32 + 12);
        const float rn = rsqrtf(((s0[0] + s0[1]) + (s0[2] + s0[3]) + (s1[0] + s1[1]) + (s1[2] + s1[3])) * (1.f / DM) + EPS);
        const float am = fmaxf(fmaxf(fmaxf(m0[0], m0[1]), fmaxf(m0[2], m0[3])), fmaxf(fmaxf(m1[0], m1[1]), fmaxf(m1[2], m1[3])));
        const float qinv = am > 0.f ? 127.f / am : 0.f;
#pragma unroll
        for (int c = 0; c < 2; ++c) { const size_t off = (size_t)t * DM + c * 1024 + lane * 16; f32x4 y[4];
#pragma unroll
            for (int q = 0; q < 2; ++q) { const u32x4 w = *(const u32x4*)(XB + off + 8 * q); y[2 * q] = (f32x4){bf2f(w.x & 0xffffu), bf2f(w.x >> 16), bf2f(w.y & 0xffffu), bf2f(w.y >> 16)}; y[2 * q + 1] = (f32x4){bf2f(w.z & 0xffffu), bf2f(w.z >> 16), bf2f(w.w & 0xffffu), bf2f(w.w >> 16)}; }
            if (out) {
#pragma unroll
                for (int q = 0; q < 4; ++q) { const f32x4 gq = *(const f32x4*)(final_g + c * 1024 + lane * 16 + 4 * q); *(f32x4*)(out + off + 4 * q) = y[q] * rn * gq; }
            } else {
                *(u32x4*)(ws + WS_XQ + off) = (u32x4){pack4_q8(y[0][0] * qinv, y[0][1] * qinv, y[0][2] * qinv, y[0][3] * qinv), pack4_q8(y[1][0] * qinv, y[1][1] * qinv, y[1][2] * qinv, y[1][3] * qinv),
                                                     pack4_q8(y[2][0] * qinv, y[2][1] * qinv, y[2][2] * qinv, y[2][3] * qinv), pack4_q8(y[3][0] * qinv, y[3][1] * qinv, y[3][2] * qinv, y[3][3] * qinv)};
            } }
        if (!out && lane == 0) { RS[t] = rn; ((float*)(ws + WS_SA))[t] = am * (1.f / 127.f); }
    }
}

#define XB_TMO      128
#define XB_XCNT(j)  (256  + 64 * (j))
#define XB_XSUB(j)  (1280 + 64 * (j))
#define XB_XGEN(j)  (2304 + 64 * (j))
#define XB_TOP      3328
#define XB_TOPGEN   3392
#define XCD_BAR_WORDS 3456
#define XB_SPIN_CAP (1u << 22)
__device__ __forceinline__ unsigned xb_ld(unsigned* p)              { return __hip_atomic_load(p, __ATOMIC_RELAXED, __HIP_MEMORY_SCOPE_AGENT); }
__device__ __forceinline__ unsigned xb_add(unsigned* p, unsigned v) { return __hip_atomic_fetch_add(p, v, __ATOMIC_RELAXED, __HIP_MEMORY_SCOPE_AGENT); }
__device__ __forceinline__ unsigned xb_xcc_id() { return (unsigned)__builtin_amdgcn_s_getreg((3 << 11) | 20) & 0xFu; }
#define XB_SPIN(cond, bar) do { unsigned _sp = 0; while (cond) { __builtin_amdgcn_s_sleep(1); \
    if ((++_sp & 255u) == 0u) { if (xb_ld(&(bar)[XB_TMO])) break; if (_sp > XB_SPIN_CAP) { atomicAdd(&(bar)[XB_TMO], 1u); break; } } } } while (0)
__device__ __forceinline__ void xcd_barrier_complete(unsigned* bar, unsigned x, unsigned& nloc, unsigned& nx) {
    const unsigned G = gridDim.x;
    unsigned sum, cnt, mine, sp = 0u;
    for (;;) {
        sum = 0u; cnt = 0u; mine = 0u;
#pragma unroll
        for (unsigned j = 0; j < 16; ++j) { const unsigned c = xb_ld(&bar[XB_XCNT(j)]); sum += c; cnt += (c > 0u) ? 1u : 0u; mine = (j == x) ? c : mine; }
        if (sum == G) break;
        __builtin_amdgcn_s_sleep(1);
        if ((++sp & 255u) == 0u) { if (xb_ld(&bar[XB_TMO])) break; if (sp > XB_SPIN_CAP) { atomicAdd(&bar[XB_TMO], 1u); break; } }
    }
    nloc = mine > 0u ? mine : 1u; nx = cnt > 0u ? cnt : 1u;
}
__device__ __forceinline__ void xcd_barrier(unsigned* bar, volatile LAS unsigned* st, const int tid) {
    asm volatile("s_waitcnt vmcnt(0)" ::: "memory");
    __syncthreads();
    if (tid == 0) {
        __builtin_amdgcn_s_waitcnt(0);
        const unsigned x = xb_xcc_id();
        unsigned nloc = st[0], nx = st[1];
        if (nloc == 0u) { xcd_barrier_complete(bar, x, nloc, nx); st[0] = nloc; st[1] = nx; }
        const unsigned old = xb_add(&bar[XB_XSUB(x)], 1u);
        const unsigned gen = old / nloc;
        if (old + 1u == (gen + 1u) * nloc) {
            __builtin_amdgcn_fence(__ATOMIC_RELEASE, "agent");
            asm volatile("s_waitcnt vmcnt(0)" ::: "memory");
            const unsigned og = xb_add(&bar[XB_TOP], 1u);
            const unsigned tg = og / nx;
            if (og + 1u == (tg + 1u) * nx) {
#pragma unroll
                for (unsigned j = 0; j < 16; ++j) __hip_atomic_fetch_add(&bar[XB_XGEN(j)], 1u, __ATOMIC_RELAXED, __HIP_MEMORY_SCOPE_AGENT);
            }
        }
        XB_SPIN(xb_ld(&bar[XB_XGEN(x)]) == gen, bar);
        __builtin_amdgcn_fence(__ATOMIC_ACQUIRE, "agent");
        asm volatile("s_waitcnt vmcnt(0)" ::: "memory");
    }
    __syncthreads();
}

static_assert(offsetof(Args, ph_lo) == 216 && offsetof(Args, pad) == 228, "Args layout");
__device__ __forceinline__ bool ph_in(int k) { const int* p = (const int*)__builtin_amdgcn_kernarg_segment_ptr(); asm volatile("" : "+s"(p)); return p[54] <= k && k < p[55]; }
__device__ __forceinline__ int arg_int(int i) { const int* p = (const int*)__builtin_amdgcn_kernarg_segment_ptr(); asm volatile("" : "+s"(p)); return p[i]; }
#define GRID_SYNC() do { const float* const* inp_ = (const float* const*)__builtin_amdgcn_kernarg_segment_ptr(); asm volatile("" : "+s"(inp_)); \
        xcd_barrier((unsigned*)inp_[26] + CW_BAR, bst, otid(wave_s)); } while (0)
#define LANE_IDS() const int tid = otid(wave_s), lane = tid & 63, wave = __builtin_amdgcn_readfirstlane(tid >> 6), gw = vcu * NWAVES + wave; (void)lane; (void)gw
#define PHASE_PTRS() const float* const* inp = args.in; unsigned char* ws = args.ws; unsigned char* wl = ws + WS_W + (size_t)l * WL_STRIDE; (void)wl; (void)inp
#define IN(k) (args.ph_lo <= (k) && (k) < args.ph_hi)
#define SEAM(k) do { if (IN(k) && IN((k) + 1)) GRID_SYNC(); } while (0)

template <int L> __device__ __forceinline__ void layer_body(const Args& args, LAS unsigned char* lds, const int wave_s, const int G, const int bx, const int vcu, const int NGW, volatile LAS unsigned* bst) {
    constexpr int l = L;
        if (IN(PH_A)) {
            PHASE_PTRS(); LANE_IDS();
            { pg8::Gemm g{(const bf16_t*)(ws + WS_XQ), (const bf16_t*)(ws + WS_WGQ + (size_t)l * 12288 * DM), T, 12288, DM / 2}; pg8::StaticOrder S; S.init(T, 12288, G, bx);
              EpiA8 E{ws, inp[16] + (size_t)l * 6144, (const float*)(ws + WS_SB) + l * 12288};
              pg8::gemm_phase<EpiA8, pg8::StaticOrder, true, true, true>(lds, g, S, E, tid); }
        }
        SEAM(PH_A);
        if (IN(PH_B)) {
            { PHASE_PTRS(); LANE_IDS(); static_assert(WO_WUKV == WO_WUQ + (size_t)1536 * 512 * 2 && WS_CKV > WS_CQ, "up-projection weights adjacent");
              pg8::Gemm g{(const bf16_t*)(ws + WS_CQ), (const bf16_t*)(wl + WO_WUQ), T, 3584, 512, (long)(WS_CKV - WS_CQ), 6}; pg8::StaticOrder S; S.init(T, 3584, G, bx);
              EpiUp E{EpiQup{(const float*)(ws + WS_CQSS), (const f32x2*)(ws + WS_ROPE), (bf16_t*)(ws + WS_QF)}, EpiKVup{(const float*)(ws + WS_CKVSS), (bf16_t*)(ws + WS_KF), (bf16_t*)(ws + WS_VF)}};
              pg8::gemm_phase<EpiUp, pg8::StaticOrder, true, true>(lds, g, S, E, tid); }
            { PHASE_PTRS(); LANE_IDS(); krp::phase(tid, ws, (const bf16_t*)(wl + WO_WA) + (size_t)12288 * DM, lds, G, vcu); }
            { PHASE_PTRS(); LANE_IDS(); na3::phase(tid, ws, inp[3] + (size_t)l * 8 * 15 * 31, lds, G, vcu); }
            { PHASE_PTRS(); LANE_IDS(); sgu::phase(tid, ws, (const bf16_t*)(wl + WO_SGUW), inp[4] + l * 1024, inp[5] + l * 1024, inp[7] + l * 1024, lds, G, vcu); }
        }
        SEAM(PH_B);
        if (IN(PH_C)) {
            { PHASE_PTRS(); LANE_IDS(); mla_attn_phase(tid, ws, lds, G, vcu); }
        }
        SEAM(PH_C);
        if (IN(PH_D)) {
            PHASE_PTRS(); LANE_IDS();
            pg8::Gemm g{(const bf16_t*)(ws + WS_OCAT), (const bf16_t*)(wl + WO_WBR), T, DM, 3072}; pg8::StaticOrder S; S.init(T, DM, G, bx);
            EpiMerge E{(const bf16_t*)(ws + WS_GATES), (bf16_t*)(ws + WS_MERGED)};
            pg8::gemm_phase<EpiMerge, pg8::StaticOrder, true, true>(lds, g, S, E, tid);
        }
        SEAM(PH_D);
        if (IN(PH_E)) {
            PHASE_PTRS(); LANE_IDS();
            pg8::Gemm g{(const bf16_t*)(ws + WS_MERGED), (const bf16_t*)(wl + WO_WOUT), T, DM, DM}; pg8::StaticOrder S; S.init(T, DM, G, bx);
            EpiOutT<true> E{inp[0], (bf16_t*)(ws + WS_XB), (float*)(ws + WS_XSS)};
            pg8::gemm_phase<EpiOutT<true>, pg8::StaticOrder, true, true>(lds, g, S, E, tid);
        }
        SEAM(PH_E);
        if (IN(PH_F)) {
            PHASE_PTRS(); LANE_IDS();
            pg8::Gemm g{(const bf16_t*)(ws + WS_XB), (const bf16_t*)(wl + WO_WQ), T, DM, DM}; pg8::StaticOrder S; S.init(T, DM, G, bx);
            EpiQuery E{(const float*)(ws + WS_XSS), (float*)(ws + WS_SC), (float*)(ws + WS_RS2)};
            pg8::gemm_phase<EpiQuery, pg8::StaticOrder, true, true>(lds, g, S, E, tid);
            if (IN(PH_G1)) { __builtin_amdgcn_fence(__ATOMIC_ACQUIRE, "agent"); pg8::Unit u; for (int ui = 0; S.next(ui, u); ++ui) psel::phase<true>(tid, ws, G, vcu, u.pm, u.pn); }
        }
        if (IN(PH_F) && IN(PH_G2)) GRID_SYNC();
        if (IN(PH_G2)) { PHASE_PTRS(); LANE_IDS(); peer_u_sliced_phase(tid, ws, (const unsigned char*)(wl + WO_PU), G, vcu); }
        if (IN(PH_G2)) GRID_SYNC();
        if (IN(PH_G2)) { PHASE_PTRS(); LANE_IDS(); peer_v_sliced_phase(tid, ws, (const unsigned char*)(wl + WO_PV), G, vcu); }
        if (IN(PH_G2)) GRID_SYNC();
        if (IN(PH_G2)) { PHASE_PTRS(); LANE_IDS(); peer_finish_phase(tid, ws, inp[24], l == DEPTH - 1 ? args.out : (float*)nullptr, G, vcu); }
}

__global__ void __launch_bounds__(NWAVES * 64, 2) mk_fwd(Args args) {
    extern __shared__ __attribute__((aligned(16))) unsigned char lds_raw[];
    LAS unsigned char* lds = (LAS unsigned char*)lds_raw;
    const int wave_s = __builtin_amdgcn_readfirstlane((int)threadIdx.x >> 6);
    const int G = gridDim.x, bx = blockIdx.x, vcu = (G % 8 == 0) ? (bx % 8) * (G / 8) + bx / 8 : bx, NGW = G * NWAVES;
    volatile LAS unsigned* bst = (volatile LAS unsigned*)(lds + LDS_BYTES - 16);
    { const int tid = otid(wave_s); if (tid == 0) { bst[0] = 0u; bst[1] = 0u; unsigned* bar = (unsigned*)args.ws + CW_BAR; (void)xb_add(&bar[XB_XCNT(xb_xcc_id())], 1u); } __syncthreads(); }
    if (IN(PH_P0)) { LANE_IDS(); p0_prologue(args, lds, gw, NGW, wave, lane); p0_key_fold(args, gw, NGW, lane); __syncthreads(); p0_quant_strips(args, lds, tid, G, bx); }
    if (args.pad < 0) cg::this_grid().sync();
    if (IN(PH_P0) && IN(PH_A)) { GRID_SYNC(); }
    if (args.layer <= 0 && 0 < args.pad) layer_body<0>(args, lds, wave_s, G, bx, vcu, NGW, bst);
    if (args.layer <= 0 && 1 < args.pad && IN(PH_G2) && IN(PH_A)) GRID_SYNC();
    if (args.layer <= 1 && 1 < args.pad) layer_body<1>(args, lds, wave_s, G, bx, vcu, NGW, bst);
}

extern "C" void kernel_launch(void* const* d_in, const int* in_sizes, int n_in, void* d_out, int out_size, void* d_ws, size_t ws_size, hipStream_t stream) {
    static int grid = 0;
    if (grid == 0) {
        if (n_in != 25 || ws_size < WS_END || out_size != T * DM) { fprintf(stderr, "kernel_launch: bad shapes: n_in %d ws %zu out %d\n", n_in, ws_size, out_size); grid = -1; return; }
        int dev = 0, cus = 0, per_cu = 0;
        if (hipGetDevice(&dev) != hipSuccess || hipDeviceGetAttribute(&cus, hipDeviceAttributeMultiprocessorCount, dev) != hipSuccess) { grid = -1; return; }
        if (hipFuncSetAttribute((const void*)mk_fwd, hipFuncAttributeMaxDynamicSharedMemorySize, LDS_BYTES) != hipSuccess) { fprintf(stderr, "kernel_launch: hipFuncSetAttribute failed\n"); grid = -1; return; }
        if (hipOccupancyMaxActiveBlocksPerMultiprocessor(&per_cu, (const void*)mk_fwd, NWAVES * 64, LDS_BYTES) != hipSuccess || per_cu < 1) { fprintf(stderr, "kernel_launch: occupancy query says %d\n", per_cu); grid = -1; return; }
        grid = cus;
    }
    if (grid < 0) return;
    Args a{};
    for (int i = 0; i < 25; ++i) a.in[i] = (const float*)d_in[i];
    a.out = (float*)d_out; a.ws = (unsigned char*)d_ws;
    a.ph_lo = 0; a.ph_hi = PH_N; a.layer = 0; a.pad = DEPTH;
    if (hipMemsetAsync((char*)d_ws + WS_CTL, 0, CTL_BYTES, stream) != hipSuccess) { fprintf(stderr, "kernel_launch: memset failed\n"); return; }
    void* kargs[] = {&a};
    const hipError_t e = hipLaunchCooperativeKernel((const void*)mk_fwd, dim3(grid), dim3(NWAVES * 64), kargs, LDS_BYTES, stream);
    if (e != hipSuccess) fprintf(stderr, "kernel_launch: cooperative launch failed: %s (grid %d)\n", hipGetErrorString(e), grid);
}
```
